# Optimizing an MI355X kernel written in HIP

```python
import math
import jax, jax.numpy as jnp
from jax import lax
import numpy as np

D_MODEL = 4096
BATCH = 4
SEQ = 2048
DEPTH = 1
DEC_BATCH = 2
DEC_SEQ = 4096
PAST_LEN = 128

N_MEM = 256
XA_HEADS = 4
XA_HEAD_DIM = D_MODEL // XA_HEADS
MLA_HEADS = 16
MLA_NOPE = 128
MLA_ROPE = 64
MLA_V = 128
Q_LORA = 1024
KV_LORA = 512
ROPE_THETA = 10000.0
Q_BLOCK = 128
MLA_WIDTH = MLA_HEADS * MLA_V
GLA_HEADS = 4
GLA_DK = 256
GLA_DV = 512
GLA_KEY = GLA_HEADS * GLA_DK
GLA_VAL = GLA_HEADS * GLA_DV
GLA_GATE_RANK = 16
GLA_GATE_NORM = 16.0
GLA_CHUNK = 64
D_FF = 4 * D_MODEL
LN_EPS = 1e-5
RMS_EPS = 1e-6
DN_ALPHA = (2.0 * DEPTH) ** 0.25
DN_BETA = (8.0 * DEPTH) ** -0.25
IN_SIZES = (Q_LORA, KV_LORA, MLA_ROPE, GLA_KEY, GLA_KEY, GLA_VAL, GLA_VAL, 2 * GLA_GATE_RANK, 2 * D_MODEL)
IN_VALUE_BLOCK = 5
IN_TOTAL = sum(IN_SIZES)

kernel_name = "hybrid_mla_gla_deepnorm_encoder"


def _layer_norm(x, g, b):
    xf = x.astype(jnp.float32)
    mu = jnp.mean(xf, -1, keepdims=True)
    var = jnp.mean(jnp.square(xf - mu), -1, keepdims=True)
    y = (xf - mu) * lax.rsqrt(var + LN_EPS)
    return (y * g.astype(jnp.float32) + b.astype(jnp.float32)).astype(x.dtype)


def _rms_norm(x, g):
    xf = x.astype(jnp.float32)
    y = xf * lax.rsqrt(jnp.mean(jnp.square(xf), -1, keepdims=True) + RMS_EPS)
    return (y * g.astype(jnp.float32)).astype(x.dtype)


def _rope_tables(seq_len):
    inv = 1.0 / (ROPE_THETA ** (jnp.arange(0, MLA_ROPE, 2, dtype=jnp.float32) / MLA_ROPE))
    ang = jnp.arange(seq_len, dtype=jnp.float32)[:, None] * inv[None, :]
    return jnp.cos(ang)[:, None, :], jnp.sin(ang)[:, None, :]


def _apply_rope(x, cos, sin):
    xf = x.astype(jnp.float32)
    x1, x2 = jnp.split(xf, 2, axis=-1)
    return jnp.concatenate([x1 * cos - x2 * sin, x2 * cos + x1 * sin], axis=-1).astype(x.dtype)


def _mla(c_q, c_kv, k_rope, q_norm, w_uq, kv_norm, w_ukv, cos, sin):
    b, s, _ = c_q.shape
    q = (_rms_norm(c_q, q_norm) @ w_uq).reshape(b, s, MLA_HEADS, MLA_NOPE + MLA_ROPE)
    q_nope = q[..., :MLA_NOPE]
    q_rope = _apply_rope(q[..., MLA_NOPE:], cos, sin)
    kv = (_rms_norm(c_kv, kv_norm) @ w_ukv).reshape(b, s, MLA_HEADS, MLA_NOPE + MLA_V)
    k_nope, v = kv[..., :MLA_NOPE], kv[..., MLA_NOPE:]
    k_r = _apply_rope(k_rope[:, :, None, :], cos, sin)[:, :, 0]
    scale = (MLA_NOPE + MLA_ROPE) ** -0.5
    n_blk = s // Q_BLOCK

    def block(qs):
        qn, qr = qs
        sc = (jnp.einsum('bqhd,bkhd->bhqk', qn, k_nope)
              + jnp.einsum('bqhr,bkr->bhqk', qr, k_r))
        p = jax.nn.softmax(sc.astype(jnp.float32) * scale, axis=-1).astype(v.dtype)
        return jnp.einsum('bhqk,bkhd->bqhd', p, v)

    to_blocks = lambda t: jnp.moveaxis(t.reshape(b, n_blk, Q_BLOCK, *t.shape[2:]), 1, 0)
    o = lax.map(block, (to_blocks(q_nope), to_blocks(q_rope)))
    return jnp.moveaxis(o, 0, 1).reshape(b, s, MLA_WIDTH)


def _gla_direction(q, k, v, log_a):
    b, h, s, dk = q.shape
    dv = v.shape[-1]
    n = s // GLA_CHUNK
    rs = lambda t: t.reshape(b, h, n, GLA_CHUNK, t.shape[-1])
    q, k, v, log_a = rs(q), rs(k), rs(v), rs(log_a)
    cum = jnp.cumsum(log_a, axis=3)
    last = cum[:, :, :, -1:, :]
    q_dec = q * jnp.exp(cum)
    k_intra = k * jnp.exp(-cum)
    k_to_end = k * jnp.exp(last - cum)
    mask = jnp.tril(jnp.ones((GLA_CHUNK, GLA_CHUNK), dtype=bool))
    attn = jnp.where(mask, jnp.einsum('bhncd,bhnjd->bhncj', q_dec, k_intra), 0.0)
    o_intra = jnp.einsum('bhncj,bhnjv->bhncv', attn, v)
    chunk_decay = jnp.exp(last[:, :, :, 0, :])

    def step(state, inp):
        q_c, k_c, v_c, dec_c = inp
        out = jnp.einsum('bhcd,bhdv->bhcv', q_c, state)
        new = dec_c[..., None] * state + jnp.einsum('bhcd,bhcv->bhdv', k_c, v_c)
        return new, out

    init = jnp.zeros((b, h, dk, dv), jnp.float32)
    mv = lambda t: jnp.moveaxis(t, 2, 0)
    _, o_inter = lax.scan(step, init, (mv(q_dec), mv(k_to_end), mv(v), mv(chunk_decay)))
    o = o_intra + jnp.moveaxis(o_inter, 0, 2)
    return o.reshape(b, h, s, dv)


def _gla(gq, gk, gv, gr, g_lr, w2, gb, norm_g):
    b, s, _ = gq.shape
    heads = lambda t, d: jnp.moveaxis(t.reshape(b, s, GLA_HEADS, d), 2, 1).astype(jnp.float32)
    q = heads(gq, GLA_DK) * (GLA_DK ** -0.5)
    k = heads(gk, GLA_DK)
    v = heads(gv, GLA_DV)
    lr = g_lr.reshape(b, s, 2, GLA_GATE_RANK)
    gate_pre = jnp.einsum('bstr,trk->tbsk', lr, w2) + gb[:, None, None, :]
    log_a = jax.nn.log_sigmoid(gate_pre.astype(jnp.float32)) / GLA_GATE_NORM
    flip = lambda t: jnp.flip(t, axis=2)
    fwd = _gla_direction(q, k, v, heads(log_a[0], GLA_DK))
    bwd = flip(_gla_direction(flip(q), flip(k), flip(v), flip(heads(log_a[1], GLA_DK))))
    o = _rms_norm(jnp.moveaxis(fwd + bwd, 1, 2), norm_g)
    o = o.reshape(b, s, GLA_VAL) * jax.nn.silu(gr.astype(jnp.float32))
    return o.astype(gq.dtype)


def _mixer(h, w_in, b_merge, q_norm, w_uq, kv_norm, w_ukv, gate_w2, gate_b, gla_norm,
           w_br_mla, w_br_gla, w_out, cos, sin):
    b, s, _ = h.shape
    offs = np.cumsum(IN_SIZES)[:-1].tolist()
    c_q, c_kv, k_rope, gq, gk, gv, gr, g_lr, g_merge = jnp.split(h @ w_in, offs, axis=-1)
    o_mla = _mla(c_q, c_kv, k_rope, q_norm, w_uq, kv_norm, w_ukv, cos, sin)
    o_gla = _gla(gq, gk, gv, gr, g_lr, gate_w2, gate_b, gla_norm)
    gates = jax.nn.sigmoid((g_merge + b_merge).astype(jnp.float32)).astype(h.dtype).reshape(b, s, 2, D_MODEL)
    merged = gates[:, :, 0] * (o_mla @ w_br_mla) + gates[:, :, 1] * (o_gla @ w_br_gla)
    return merged @ w_out


def _cross_attn(h, mem, wq, wkv, wo):
    b, s, _ = h.shape
    q = (h @ wq).reshape(b, s, XA_HEADS, XA_HEAD_DIM)
    kv = (mem @ wkv).reshape(b, mem.shape[1], 2, XA_HEADS, XA_HEAD_DIM)
    k, v = kv[:, :, 0], kv[:, :, 1]
    sc = jnp.einsum('bqhd,bmhd->bhqm', q, k).astype(jnp.float32) * (XA_HEAD_DIM ** -0.5)
    p = jax.nn.softmax(sc, axis=-1).astype(h.dtype)
    o = jnp.einsum('bhqm,bmhd->bqhd', p, v).reshape(b, s, D_MODEL)
    return o @ wo


def _encode(x, mem, ln_in_g, ln_in_b, w_in, b_merge, mla_q_norm, w_uq, mla_kv_norm, w_ukv,
            gla_gate_w2, gla_gate_b, gla_norm, w_branch_mla, w_branch_gla, w_mix_out,
            ln1_g, ln1_b, xa_wq, xa_wkv, xa_wo, ln2_g, ln2_b, mlp_w1, mlp_w2, ln3_g, ln3_b):
    cos, sin = _rope_tables(x.shape[1])
    h = _layer_norm(x, ln_in_g, ln_in_b)
    for l in range(DEPTH):
        mix = _mixer(h, w_in[l], b_merge[l], mla_q_norm[l], w_uq[l], mla_kv_norm[l], w_ukv[l],
                     gla_gate_w2[l], gla_gate_b[l], gla_norm[l], w_branch_mla[l], w_branch_gla[l],
                     w_mix_out[l], cos, sin)
        h = _layer_norm(DN_ALPHA * h + mix, ln1_g[l], ln1_b[l])
        h = _layer_norm(DN_ALPHA * h + _cross_attn(h, mem, xa_wq[l], xa_wkv[l], xa_wo[l]), ln2_g[l], ln2_b[l])
        ff = jnp.square(jax.nn.relu(h @ mlp_w1[l])) @ mlp_w2[l]
        h = _layer_norm(DN_ALPHA * h + ff, ln3_g[l], ln3_b[l])
    return h


def _w(k, shape, fan_in, scale=1.0):
    return jax.random.normal(k, shape, jnp.float32) * (scale * fan_in ** -0.5)


def setup_inputs(seed: int = 0) -> dict:
    key = jax.random.key(seed)
    ks = iter(jax.random.split(key, 64))
    gain = lambda shape: 1.0 + 0.02 * jax.random.normal(next(ks), shape, jnp.float32)
    bias = lambda shape: 0.02 * jax.random.normal(next(ks), shape, jnp.float32)
    L = DEPTH
    x_prompt = jax.random.normal(next(ks), (BATCH, SEQ, D_MODEL), jnp.float32)
    x_sample = jax.random.normal(next(ks), (DEC_BATCH, DEC_SEQ, D_MODEL), jnp.float32)
    mem_prompt = jax.random.normal(next(ks), (BATCH, N_MEM, D_MODEL), jnp.float32)
    mem_sample = jax.random.normal(next(ks), (DEC_BATCH, N_MEM, D_MODEL), jnp.float32)
    ln_in_g = gain((D_MODEL,))
    ln_in_b = bias((D_MODEL,))
    w_in = jnp.concatenate(
        [_w(next(ks), (L, D_MODEL, n), D_MODEL, DN_BETA if i == IN_VALUE_BLOCK else 1.0)
         for i, n in enumerate(IN_SIZES)], axis=-1)
    b_merge = bias((L, 2 * D_MODEL))
    mla_q_norm = gain((L, Q_LORA))
    w_uq = _w(next(ks), (L, Q_LORA, MLA_HEADS * (MLA_NOPE + MLA_ROPE)), Q_LORA)
    mla_kv_norm = gain((L, KV_LORA))
    w_uk = _w(next(ks), (L, KV_LORA, MLA_HEADS, MLA_NOPE), KV_LORA)
    w_uv = _w(next(ks), (L, KV_LORA, MLA_HEADS, MLA_V), KV_LORA, DN_BETA)
    w_ukv = jnp.concatenate([w_uk, w_uv], axis=-1).reshape(L, KV_LORA, MLA_HEADS * (MLA_NOPE + MLA_V))
    gla_gate_w2 = _w(next(ks), (L, 2, GLA_GATE_RANK, GLA_KEY), GLA_GATE_RANK)
    gla_gate_b = bias((L, 2, GLA_KEY))
    gla_norm = gain((L, GLA_DV))
    w_branch_mla = _w(next(ks), (L, MLA_WIDTH, D_MODEL), MLA_WIDTH)
    w_branch_gla = _w(next(ks), (L, GLA_VAL, D_MODEL), GLA_VAL)
    w_mix_out = _w(next(ks), (L, D_MODEL, D_MODEL), D_MODEL, DN_BETA)
    ln1_g = gain((L, D_MODEL))
    ln1_b = bias((L, D_MODEL))
    xa_wq = _w(next(ks), (L, D_MODEL, D_MODEL), D_MODEL)
    xa_wkv = jnp.concatenate([_w(next(ks), (L, D_MODEL, D_MODEL), D_MODEL),
                              _w(next(ks), (L, D_MODEL, D_MODEL), D_MODEL, DN_BETA)], axis=-1)
    xa_wo = _w(next(ks), (L, D_MODEL, D_MODEL), D_MODEL, DN_BETA)
    ln2_g = gain((L, D_MODEL))
    ln2_b = bias((L, D_MODEL))
    mlp_w1 = _w(next(ks), (L, D_MODEL, D_FF), D_MODEL)
    mlp_w2 = _w(next(ks), (L, D_FF, D_MODEL), D_FF, DN_BETA)
    ln3_g = gain((L, D_MODEL))
    ln3_b = bias((L, D_MODEL))
    return {"x_prompt": x_prompt, "x_sample": x_sample, "mem_prompt": mem_prompt, "mem_sample": mem_sample,
            "ln_in_g": ln_in_g, "ln_in_b": ln_in_b, "w_in": w_in, "b_merge": b_merge,
            "mla_q_norm": mla_q_norm, "w_uq": w_uq, "mla_kv_norm": mla_kv_norm, "w_ukv": w_ukv,
            "gla_gate_w2": gla_gate_w2, "gla_gate_b": gla_gate_b, "gla_norm": gla_norm,
            "w_branch_mla": w_branch_mla, "w_branch_gla": w_branch_gla, "w_mix_out": w_mix_out,
            "ln1_g": ln1_g, "ln1_b": ln1_b, "xa_wq": xa_wq, "xa_wkv": xa_wkv, "xa_wo": xa_wo,
            "ln2_g": ln2_g, "ln2_b": ln2_b, "mlp_w1": mlp_w1, "mlp_w2": mlp_w2,
            "ln3_g": ln3_g, "ln3_b": ln3_b}


def reference(x_prompt, x_sample, mem_prompt, mem_sample, ln_in_g, ln_in_b, w_in, b_merge,
              mla_q_norm, w_uq, mla_kv_norm, w_ukv, gla_gate_w2, gla_gate_b, gla_norm,
              w_branch_mla, w_branch_gla, w_mix_out, ln1_g, ln1_b, xa_wq, xa_wkv, xa_wo,
              ln2_g, ln2_b, mlp_w1, mlp_w2, ln3_g, ln3_b):
    params = (ln_in_g, ln_in_b, w_in, b_merge, mla_q_norm, w_uq, mla_kv_norm, w_ukv,
              gla_gate_w2, gla_gate_b, gla_norm, w_branch_mla, w_branch_gla, w_mix_out,
              ln1_g, ln1_b, xa_wq, xa_wkv, xa_wo, ln2_g, ln2_b, mlp_w1, mlp_w2, ln3_g, ln3_b)
    y_prompt = _encode(x_prompt, mem_prompt, *params)
    y_sample = _encode(x_sample, mem_sample, *params)
    return (y_prompt, y_sample)
```

```cpp
#include <hip/hip_runtime.h>
#include <cstdio>
#include <cstdint>

#define GAS __attribute__((address_space(1)))
#define LAS __attribute__((address_space(3)))
typedef unsigned short bf16;
typedef short bf16x8 __attribute__((ext_vector_type(8)));
typedef short s16x4 __attribute__((ext_vector_type(4)));
typedef short v4i16_t __attribute__((ext_vector_type(4)));
typedef float f32x2 __attribute__((ext_vector_type(2)));
typedef float f32x4 __attribute__((ext_vector_type(4)));
typedef float f32x16 __attribute__((ext_vector_type(16)));
typedef unsigned u32x2 __attribute__((ext_vector_type(2)));
typedef unsigned u32x4 __attribute__((ext_vector_type(4)));
typedef __bf16 bf16x2_t __attribute__((ext_vector_type(2)));
typedef GAS unsigned gu32;

#define DI __device__ __forceinline__
#define LDS_WAIT() asm volatile("s_waitcnt lgkmcnt(0)" ::: "memory")
#define VM_WAIT() asm volatile("s_waitcnt vmcnt(0)" ::: "memory")
#define RLX_AGENT __ATOMIC_RELAXED, __HIP_MEMORY_SCOPE_AGENT

DI unsigned pk2(float lo, float hi) { f32x2 v = {lo, hi}; bf16x2_t b = __builtin_convertvector(v, bf16x2_t); return __builtin_bit_cast(unsigned, b); }
DI float bflo(unsigned u) { return __uint_as_float(u << 16); }
DI float bfhi(unsigned u) { return __uint_as_float(u & 0xffff0000u); }
DI float bf1(bf16 h) { return __uint_as_float(((unsigned)h) << 16); }
DI float wave_sum(float v) {
#pragma unroll
    for (int o = 1; o < 64; o <<= 1) v += __shfl_xor(v, o);
    return v;
}
DI float fexp2(float x) { return __builtin_amdgcn_exp2f(x); }
DI float frcp(float x) { return __builtin_amdgcn_rcpf(x); }

constexpr int DM = 4096, M = 16384;
constexpr int NP = 7936;
constexpr int PC_CQ = 0, PC_CKV = 1024, PC_KROPE = 1536, PC_GLR = 1600, PC_GQ = 1792, PC_GK = 2816, PC_GV = 3840, PC_GR = 5888;
constexpr int IN_TOTAL = 15968;
constexpr float LN_EPS = 1e-5f, RMS_EPS = 1e-6f;
constexpr float DN_ALPHA = 1.189207115002721f;
constexpr float LOG2E = 1.4426950408889634f;
constexpr float CQ_MLA = 0.07216878364870322f * LOG2E;
constexpr float CQ_XA = 0.03125f * LOG2E;

constexpr size_t MiB = 1u << 20;
constexpr size_t WS_CTL = 0, CTL_ZERO_BYTES = 1 * MiB;
constexpr size_t WS_ROPE = 1 * MiB;
constexpr size_t WS_RSTD = 2 * MiB;
constexpr size_t WS_KR = 3 * MiB;
constexpr size_t WS_MEMB = 5 * MiB;
constexpr size_t WS_WUQ = 17 * MiB, WS_WUKV = 23 * MiB, WS_WBRA = 27 * MiB, WS_WBRB = 43 * MiB, WS_WOUT = 59 * MiB, WS_WXQ = 91 * MiB,
                 WS_WXKV = 123 * MiB, WS_WXO = 187 * MiB, WS_W1 = 219 * MiB, WS_W2 = 347 * MiB, WS_WIN = 475 * MiB;
constexpr size_t WS_Q = 475 * MiB;
constexpr size_t WS_H = 601 * MiB;
constexpr size_t WS_P = 729 * MiB;
constexpr size_t WS_CUM = 977 * MiB;
constexpr size_t WS_KV = 1105 * MiB;
constexpr size_t WS_OMLA = 1233 * MiB;
constexpr size_t WS_GLAF = 1297 * MiB, WS_GLAB = 1361 * MiB;
constexpr size_t WS_END = 1425 * MiB;
constexpr size_t WS_OGLA = WS_KV;
constexpr size_t WS_MERGED = WS_CUM;
constexpr size_t WS_QX = WS_P;
constexpr size_t WS_KMEM = WS_P + 128 * MiB;
constexpr size_t WS_VT = WS_P + 140 * MiB;
constexpr size_t WS_PX = WS_P + 152 * MiB;
constexpr size_t WS_OX = WS_CUM;
constexpr size_t WS_HID = WS_P;
static_assert(WS_HID + (size_t)M * 16384 * 2 <= WS_END, "hid fits");
static_assert(WS_PX + (size_t)M * 1024 * 2 <= WS_CUM, "px fits");
constexpr int CW_BAR = 4096;
constexpr int CW_QUEUE = 16384;

constexpr int RING_BYTES = 151552;
constexpr int MISC_OFF = RING_BYTES;
constexpr int LDS_BYTES = 159744;

#define XB_TMO      128
#define XB_XCNT(j)  (256  + 64 * (j))
#define XB_XSUB(j)  (1280 + 64 * (j))
#define XB_XGEN(j)  (2304 + 64 * (j))
#define XB_TOP      3328
#define XB_TOPGEN   3392
#define XCD_BAR_WORDS 3456
#define XB_SPIN_CAP (1u << 18)
DI unsigned xb_ld(unsigned* p)              { return __hip_atomic_load(p, __ATOMIC_RELAXED, __HIP_MEMORY_SCOPE_AGENT); }
DI unsigned xb_add(unsigned* p, unsigned v) { return __hip_atomic_fetch_add(p, v, __ATOMIC_RELAXED, __HIP_MEMORY_SCOPE_AGENT); }
DI unsigned xb_xcc_id() { return (unsigned)__builtin_amdgcn_s_getreg((3 << 11) | 20) & 0xFu; }
#define XB_SPIN(cond, bar) do { unsigned _sp = 0; while (cond) { __builtin_amdgcn_s_sleep(1); \
    if ((++_sp & 255u) == 0u) { if (xb_ld(&(bar)[XB_TMO])) break; if (_sp > XB_SPIN_CAP) { atomicAdd(&(bar)[XB_TMO], 1u); break; } } } } while (0)
struct XcdBarrier { unsigned* bar; unsigned x; volatile LAS unsigned* st; };
DI XcdBarrier xcd_barrier_post(unsigned* bar, volatile LAS unsigned* st) {
    XcdBarrier b; b.bar = bar; b.x = xb_xcc_id(); b.st = st;
    if (threadIdx.x == 0) (void)xb_add(&bar[XB_XCNT(b.x)], 1u);
    return b;
}
DI void xcd_barrier_complete(unsigned* bar, unsigned x, unsigned& nloc, unsigned& nx) {
    const unsigned G = gridDim.x * gridDim.y * gridDim.z;
    unsigned sum, cnt, mine, sp = 0u;
    for (;;) {
        sum = 0u; cnt = 0u; mine = 0u;
#pragma unroll
        for (unsigned j = 0; j < 16; ++j) { const unsigned c = xb_ld(&bar[XB_XCNT(j)]); sum += c; cnt += (c > 0u) ? 1u : 0u; mine = (j == x) ? c : mine; }
        if (sum == G) break;
        __builtin_amdgcn_s_sleep(1);
        if ((++sp & 255u) == 0u) { if (xb_ld(&bar[XB_TMO])) break; if (sp > XB_SPIN_CAP) { atomicAdd(&bar[XB_TMO], 1u); break; } }
    }
    nloc = mine > 0u ? mine : 1u; nx = cnt > 0u ? cnt : 1u;
}
DI void xcd_barrier(const XcdBarrier& b) {
    asm volatile("s_waitcnt vmcnt(0)" ::: "memory");
    __syncthreads();
    if (threadIdx.x == 0) {
        unsigned* bar = b.bar;
        __builtin_amdgcn_s_waitcnt(0);
        unsigned nloc = b.st[0], nx = b.st[1];
        if (nloc == 0u) { xcd_barrier_complete(bar, b.x, nloc, nx); b.st[0] = nloc; b.st[1] = nx; }
        const unsigned old = xb_add(&bar[XB_XSUB(b.x)], 1u);
        const unsigned gen = old / nloc;
        if (old + 1u == (gen + 1u) * nloc) {
            __builtin_amdgcn_fence(__ATOMIC_RELEASE, "agent");
            asm volatile("s_waitcnt vmcnt(0)" ::: "memory");
            const unsigned og = xb_add(&bar[XB_TOP], 1u);
            const unsigned tg = og / nx;
            if (og + 1u == (tg + 1u) * nx) xb_add(&bar[XB_TOPGEN], 1u);
            else XB_SPIN(xb_ld(&bar[XB_TOPGEN]) == tg, bar);
            __builtin_amdgcn_fence(__ATOMIC_ACQUIRE, "agent");
            xb_add(&bar[XB_XGEN(b.x)], 1u);
            asm volatile("s_waitcnt vmcnt(0)" ::: "memory");
        } else {
            XB_SPIN(xb_ld(&bar[XB_XGEN(b.x)]) == gen, bar);
            __builtin_amdgcn_fence(__ATOMIC_ACQUIRE, "agent");
            asm volatile("s_waitcnt vmcnt(0)" ::: "memory");
        }
    }
    __syncthreads();
}

namespace pg8 {
constexpr int BM = 256, BK = 64, HALF = 128, HTB = HALF * BK * 2, STAGE_BYTES = 8 * HTB, NXCD = 8, WGM = 8;
DI int lds_byte(int r, int c) { const int st = (r >> 4) * 2 + (c >> 5), rr = r & 15, cc = c & 31, ob = rr * 64 + cc * 2; return st * 1024 + (ob ^ (((ob >> 9) & 1) << 5)); }
DI void stage_rc(int b, int& R, int& C) { const int st = b / 1024, sb = b % 1024, swz = sb ^ (((sb >> 9) & 1) << 5); R = (st >> 1) * 16 + swz / 64; C = (st & 1) * 32 + (swz % 64) / 2; }
DI int perm32(int rho) { const int n = rho >> 4, i = rho & 15; return 8 * (i >> 2) + 4 * n + (i & 3); }

struct Unit { int pm, pn, aux; const char* A; const char* B; };
struct GridOrder {
    int nM, nN, nwg, G, c;
    DI void init(int nM_, int nN_, int G_, int c_) { nM = nM_; nN = nN_; nwg = nM * nN; G = G_; c = c_; }
    DI bool tile(int i, int& pm, int& pn) const {
        const long L = (long)i * G + c; if (L >= nwg) return false;
        int wgid = (int)L; { const int q = nwg / NXCD, r = nwg % NXCD, xcd = wgid % NXCD, off = wgid / NXCD; wgid = (xcd < r ? xcd * (q + 1) : r * (q + 1) + (xcd - r) * q) + off; }
        const int nig = WGM * nN, gid = wgid / nig, fm = gid * WGM, gsz = (nM - fm) < WGM ? (nM - fm) : WGM;
        pm = fm + ((wgid % nig) % gsz); pn = (wgid % nig) / gsz; return true;
    }
};
struct SchedStd {
    GridOrder o; const char* A; const char* B; size_t ast, bst;
    DI void init(int nM, int nN, int G, int c, const void* A_, int lda, const void* B_, int ldb) { o.init(nM, nN, G, c); A = (const char*)A_; B = (const char*)B_; ast = (size_t)256 * lda * 2; bst = (size_t)256 * ldb * 2; }
    DI bool next(int i, Unit& u) const { int pm, pn; if (!o.tile(i, pm, pn)) return false; u.pm = pm; u.pn = pn; u.aux = 0; u.A = A + (size_t)pm * ast; u.B = B + (size_t)pn * bst; return true; }
};

template <class Op> struct EpiRow8 {
    static constexpr bool PERM = true, AFTER_DRAIN = false;
    Op op;
    DI void operator()(const f32x4 (&acc)[2][2][4][2], const Unit& u, int wr, int wc, int fr, int fq) const {
        const int row0 = u.pm * BM + wr * 64 + fr, col0 = u.pn * BM + wc * 32 + 8 * fq;
#pragma unroll
        for (int ai = 0; ai < 2; ++ai)
#pragma unroll
            for (int m = 0; m < 4; ++m) { const int row = row0 + ai * HALF + m * 16;
#pragma unroll
                for (int bj = 0; bj < 2; ++bj) op(u, row, col0 + bj * HALF, acc[ai][bj][m][0], acc[ai][bj][m][1]); }
    }
};

template <class Epi, class Sched, bool ALIGN_EPI>
DI void gemm_phase(LAS unsigned char* lds, const int K, const int lda, const int ldb, const Sched& S, const Epi& E) {
    int tid_ = threadIdx.x; asm volatile("" : "+v"(tid_));
    const int tid = tid_, wid = __builtin_amdgcn_readfirstlane(tid >> 6), lane = tid & 63, wr = wid >> 2, wc = wid & 3, fr = lane & 15, fq = lane >> 4;
    const int nt = K / BK;
    unsigned voffA[2], voffB[2];
#pragma unroll
    for (int i = 0; i < 2; ++i) { int R, C; stage_rc(tid * 16 + i * 8192, R, C); const int Rb = Epi::PERM ? ((R & ~31) + perm32(R & 31)) : R;
        voffA[i] = (unsigned)(R * lda + C) * 2u; voffB[i] = (unsigned)(Rb * ldb + C) * 2u; }
    const size_t kstep = (size_t)(BK * 2);
    const size_t hstepA = (size_t)HALF * lda * 2, hstepB = (size_t)HALF * ldb * 2;
    const unsigned ldsw = (unsigned)wid * 1024u;
    const int aoff = lds_byte(wr * 64 + fr, fq * 8), boff = lds_byte(wc * 32 + fr, fq * 8);
#define PG8_SA(b, h) (((b) * 2 + (h)) * HTB)
#define PG8_SB(b, h) ((4 + (b) * 2 + (h)) * HTB)
#define PG8_STAGE(bufoff, gbase, voff) do { _Pragma("unroll") for (int _i = 0; _i < 2; ++_i) \
        __builtin_amdgcn_global_load_lds((const unsigned*)((const char*)(gbase) + (voff)[_i]), (LAS unsigned*)(lds + (bufoff) + ldsw + _i * 8192), 16, 0, 0); } while (0)
#define PG8_LDA(dst, b, h) do { _Pragma("unroll") for (int m = 0; m < 4; ++m) _Pragma("unroll") for (int k = 0; k < 2; ++k) dst[m][k] = *(const LAS bf16x8*)(lds + PG8_SA(b, h) + aoff + m * 2048 + k * 1024); } while (0)
#define PG8_LDB(dst, b, h) do { _Pragma("unroll") for (int n = 0; n < 2; ++n) _Pragma("unroll") for (int k = 0; k < 2; ++k) dst[n][k] = *(const LAS bf16x8*)(lds + PG8_SB(b, h) + boff + n * 2048 + k * 1024); } while (0)
#define PG8_MMA(ai, bj, At, Bt) do { __builtin_amdgcn_s_setprio(1); _Pragma("unroll") for (int m = 0; m < 4; ++m) _Pragma("unroll") for (int n = 0; n < 2; ++n) _Pragma("unroll") for (int k = 0; k < 2; ++k) \
        acc[ai][bj][m][n] = __builtin_amdgcn_mfma_f32_16x16x32_bf16(Bt[n][k], At[m][k], acc[ai][bj][m][n], 0, 0, 0); __builtin_amdgcn_s_setprio(0); } while (0)
#define PG8_WAIT_V(n) asm volatile("s_waitcnt vmcnt(" #n ")" ::: "memory")
#define PG8_WAIT_L(n) asm volatile("s_waitcnt lgkmcnt(" #n ")" ::: "memory")
#define PG8_BAR __builtin_amdgcn_s_barrier()
#define PG8_SCHED __builtin_amdgcn_sched_barrier(0)
    Unit cur, nxt; int ui = 0;
    if (!S.next(0, cur)) return;
    f32x4 acc[2][2][4][2];
#pragma unroll
    for (int a = 0; a < 2; ++a)
#pragma unroll
        for (int b = 0; b < 2; ++b)
#pragma unroll
            for (int m = 0; m < 4; ++m)
#pragma unroll
                for (int n = 0; n < 2; ++n) acc[a][b][m][n] = (f32x4){0.f, 0.f, 0.f, 0.f};
    bf16x8 At[4][2], B0[2][2], B1[2][2];
    const char* cA = cur.A; const char* cB = cur.B;
    PG8_STAGE(PG8_SB(0, 0), cB, voffB); PG8_STAGE(PG8_SB(0, 1), cB + hstepB, voffB); PG8_STAGE(PG8_SA(0, 0), cA, voffA); PG8_STAGE(PG8_SA(0, 1), cA + hstepA, voffA);
    if (wr == 1) PG8_BAR;
    PG8_WAIT_V(2); PG8_BAR;
    PG8_STAGE(PG8_SB(1, 0), cB + kstep, voffB); PG8_STAGE(PG8_SA(1, 0), cA + kstep, voffA); PG8_STAGE(PG8_SB(1, 1), cB + hstepB + kstep, voffB);
    PG8_WAIT_V(6); PG8_BAR;
    for (;;) {
        const bool has_next = S.next(ui + 1, nxt);
        const char* nA = has_next ? nxt.A : cA; const char* nB = has_next ? nxt.B : cB;
#pragma nounroll
        for (int t = 0; t < nt; t += 2) {
            const bool last = (t == nt - 2);
            const char* a1 = cA + (size_t)(t + 1) * kstep;
            const char* a2 = last ? nA : cA + (size_t)(t + 2) * kstep; const char* b2 = last ? nB : cB + (size_t)(t + 2) * kstep;
            const char* a3 = a2 + kstep; const char* b3 = b2 + kstep;
            PG8_LDB(B0, 0, 0); PG8_LDB(B1, 0, 1); PG8_SCHED; PG8_LDA(At, 0, 0); PG8_STAGE(PG8_SA(1, 1), a1 + hstepA, voffA);
            PG8_WAIT_V(8); PG8_WAIT_L(0); PG8_BAR; PG8_MMA(0, 0, At, B0); PG8_MMA(0, 1, At, B1); PG8_BAR; PG8_SCHED;
            PG8_LDA(At, 0, 1); PG8_STAGE(PG8_SB(0, 0), b2, voffB); PG8_STAGE(PG8_SB(0, 1), b2 + hstepB, voffB); PG8_STAGE(PG8_SA(0, 0), a2, voffA);
            PG8_WAIT_V(8); PG8_WAIT_L(0); PG8_BAR; PG8_MMA(1, 0, At, B0); PG8_MMA(1, 1, At, B1); PG8_BAR; PG8_SCHED;
            PG8_LDB(B0, 1, 0); PG8_LDB(B1, 1, 1); PG8_SCHED; PG8_LDA(At, 1, 0); PG8_STAGE(PG8_SA(0, 1), a2 + hstepA, voffA);
            PG8_WAIT_V(8); PG8_WAIT_L(0); PG8_BAR; PG8_MMA(0, 0, At, B0); PG8_MMA(0, 1, At, B1); PG8_BAR; PG8_SCHED;
            PG8_LDA(At, 1, 1); PG8_STAGE(PG8_SB(1, 0), b3, voffB); PG8_STAGE(PG8_SB(1, 1), b3 + hstepB, voffB); PG8_STAGE(PG8_SA(1, 0), a3, voffA);
            PG8_WAIT_V(8); PG8_WAIT_L(0); PG8_BAR; PG8_MMA(1, 0, At, B0); PG8_MMA(1, 1, At, B1); PG8_BAR; PG8_SCHED;
        }
        if constexpr (ALIGN_EPI) { if (wr == 0) PG8_BAR; }
        if constexpr (!Epi::AFTER_DRAIN) { E(acc, cur, wr, wc, fr, fq); }
        if (!has_next) break;
#pragma unroll
        for (int a = 0; a < 2; ++a)
#pragma unroll
            for (int b = 0; b < 2; ++b)
#pragma unroll
                for (int m = 0; m < 4; ++m)
#pragma unroll
                    for (int n = 0; n < 2; ++n) acc[a][b][m][n] = (f32x4){0.f, 0.f, 0.f, 0.f};
        cur = nxt; cA = nA; cB = nB; ++ui;
        if constexpr (ALIGN_EPI) { if (wr == 1) PG8_BAR; }
    }
    PG8_WAIT_V(0);
    if constexpr (!ALIGN_EPI) { if (wr == 0) PG8_BAR; }
    PG8_BAR;
    if constexpr (Epi::AFTER_DRAIN) { E.fused(acc, cur, wr, wc, fr, fq, lds, wid, lane); }
#undef PG8_SA
#undef PG8_SB
#undef PG8_STAGE
#undef PG8_LDA
#undef PG8_LDB
#undef PG8_MMA
#undef PG8_WAIT_V
#undef PG8_WAIT_L
#undef PG8_BAR
#undef PG8_SCHED
}
}

DI u32x4 pack8(f32x4 a, f32x4 b) { u32x4 w; w.x = pk2(a[0], a[1]); w.y = pk2(a[2], a[3]); w.z = pk2(b[0], b[1]); w.w = pk2(b[2], b[3]); return w; }
DI void unpack8(u32x4 w, f32x4& a, f32x4& b) { a = (f32x4){bflo(w.x), bfhi(w.x), bflo(w.y), bfhi(w.y)}; b = (f32x4){bflo(w.z), bfhi(w.z), bflo(w.w), bfhi(w.w)}; }
DI int seq_pos(int row) { return row < 8192 ? (row & 2047) : (row & 4095); }
DI int seq_of_pm(int pm) { return pm < 32 ? (pm >> 3) : 4 + ((pm - 32) >> 4); }

struct OpPlain { bf16* O; int ldc;
    DI void operator()(const pg8::Unit&, int row, int col, f32x4 v0, f32x4 v1) const { *(u32x4*)(O + (size_t)row * ldc + col) = pack8(v0, v1); } };
struct OpG1 { bf16* P; bf16* G; const float* bm;
    DI void operator()(const pg8::Unit& u, int row, int col, f32x4 v0, f32x4 v1) const {
        if (u.pn < 31) { *(u32x4*)(P + (size_t)row * NP + col) = pack8(v0, v1); }
        else { const int c = col - NP; const f32x4 b0 = *(const f32x4*)(bm + c), b1 = *(const f32x4*)(bm + c + 4);
#pragma unroll
            for (int j = 0; j < 4; ++j) { v0[j] = frcp(1.f + fexp2(-(v0[j] + b0[j]) * LOG2E)); v1[j] = frcp(1.f + fexp2(-(v1[j] + b1[j]) * LOG2E)); }
            *(u32x4*)(G + (size_t)row * 8192 + c) = pack8(v0, v1); }
    } };
struct OpQ { bf16* Q; const float* rstd; const float* cosT; const float* sinT;
    DI void operator()(const pg8::Unit&, int row, int col, f32x4 v0, f32x4 v1) const {
        const float r = rstd[row]; v0 *= r; v1 *= r;
        const int w = col % 192;
        if (w >= 128) { const int i0 = (w - 128) >> 1, pos = seq_pos(row);
            const f32x4 c = *(const f32x4*)(cosT + pos * 32 + i0), s = *(const f32x4*)(sinT + pos * 32 + i0);
            const f32x4 a0 = v0, a1 = v1;
            v0[0] = a0[0] * c[0] - a0[1] * s[0]; v0[1] = a0[1] * c[0] + a0[0] * s[0];
            v0[2] = a0[2] * c[1] - a0[3] * s[1]; v0[3] = a0[3] * c[1] + a0[2] * s[1];
            v1[0] = a1[0] * c[2] - a1[1] * s[2]; v1[1] = a1[1] * c[2] + a1[0] * s[2];
            v1[2] = a1[2] * c[3] - a1[3] * s[3]; v1[3] = a1[3] * c[3] + a1[2] * s[3]; }
        *(u32x4*)(Q + (size_t)row * 3072 + col) = pack8(v0, v1);
    } };
struct OpKV { bf16* KV; const float* rstd;
    DI void operator()(const pg8::Unit&, int row, int col, f32x4 v0, f32x4 v1) const { const float r = rstd[row]; *(u32x4*)(KV + (size_t)row * 4096 + col) = pack8(v0 * r, v1 * r); } };
struct OpT { bf16* T; const bf16* G;
    DI void operator()(const pg8::Unit&, int row, int col, f32x4 v0, f32x4 v1) const { f32x4 g0, g1; unpack8(*(const u32x4*)(G + (size_t)row * 8192 + col), g0, g1);
        *(u32x4*)(T + (size_t)row * 4096 + col) = pack8(g0 * v0, g1 * v1); } };
struct OpM { bf16* T; const bf16* G;
    DI void operator()(const pg8::Unit&, int row, int col, f32x4 v0, f32x4 v1) const { f32x4 g0, g1, t0, t1; unpack8(*(const u32x4*)(G + (size_t)row * 8192 + 4096 + col), g0, g1);
        unpack8(*(const u32x4*)(T + (size_t)row * 4096 + col), t0, t1); *(u32x4*)(T + (size_t)row * 4096 + col) = pack8(t0 + g0 * v0, t1 + g1 * v1); } };
struct OpY { float* Y; const bf16* H;
    DI void operator()(const pg8::Unit&, int row, int col, f32x4 v0, f32x4 v1) const { f32x4 h0, h1; unpack8(*(const u32x4*)(H + (size_t)row * 4096 + col), h0, h1);
        float* y = Y + (size_t)row * 4096 + col; *(f32x4*)y = h0 * DN_ALPHA + v0; *(f32x4*)(y + 4) = h1 * DN_ALPHA + v1; } };
struct OpRelu2 { bf16* O;
    DI void operator()(const pg8::Unit&, int row, int col, f32x4 v0, f32x4 v1) const {
#pragma unroll
        for (int j = 0; j < 4; ++j) { const float a = fmaxf(v0[j], 0.f), b = fmaxf(v1[j], 0.f); v0[j] = a * a; v1[j] = b * b; }
        *(u32x4*)(O + (size_t)row * 16384 + col) = pack8(v0, v1); } };
struct OpKVmem { bf16* KMEM; bf16* VT;
    DI void operator()(const pg8::Unit& u, int row, int col, f32x4 v0, f32x4 v1) const {
        if (u.aux == 0) *(u32x4*)(KMEM + (size_t)row * 4096 + col) = pack8(v0, v1);
        else *(u32x4*)(VT + (size_t)(u.aux - 1) * (4096 * 256) + (size_t)row * 256 + col) = pack8(v0, v1); } };

struct EpiSoftmax {
    static constexpr bool PERM = true, AFTER_DRAIN = true;
    bf16* PX;
    DI void fused(f32x4 (&acc)[2][2][4][2], const pg8::Unit& u, int wr, int wc, int fr, int fq, LAS unsigned char* lds, int wid, int lane) const {
        LAS float* T1 = (LAS float*)lds; LAS float* T2 = (LAS float*)(lds + 4096);
        float mx[2][4];
#pragma unroll
        for (int ai = 0; ai < 2; ++ai)
#pragma unroll
            for (int m = 0; m < 4; ++m) { float v = -3.0e38f;
#pragma unroll
                for (int bj = 0; bj < 2; ++bj)
#pragma unroll
                    for (int n = 0; n < 2; ++n)
#pragma unroll
                        for (int j = 0; j < 4; ++j) v = fmaxf(v, acc[ai][bj][m][n][j]);
                v = fmaxf(v, __shfl_xor(v, 16)); v = fmaxf(v, __shfl_xor(v, 32));
                if (fq == 0) T1[(ai * 128 + wr * 64 + m * 16 + fr) * 4 + wc] = v; }
        LDS_WAIT(); __builtin_amdgcn_s_barrier(); asm volatile("" ::: "memory");
#pragma unroll
        for (int ai = 0; ai < 2; ++ai)
#pragma unroll
            for (int m = 0; m < 4; ++m) { const int r = ai * 128 + wr * 64 + m * 16 + fr; const f32x4 t = *(const LAS f32x4*)(T1 + r * 4);
                const float mr = fmaxf(fmaxf(t[0], t[1]), fmaxf(t[2], t[3])); float s = 0.f;
#pragma unroll
                for (int bj = 0; bj < 2; ++bj)
#pragma unroll
                    for (int n = 0; n < 2; ++n)
#pragma unroll
                        for (int j = 0; j < 4; ++j) { const float p = fexp2(acc[ai][bj][m][n][j] - mr); acc[ai][bj][m][n][j] = p; s += p; }
                s += __shfl_xor(s, 16); s += __shfl_xor(s, 32);
                if (fq == 0) T2[r * 4 + wc] = s; }
        LDS_WAIT(); __builtin_amdgcn_s_barrier(); asm volatile("" ::: "memory");
        const int row0 = u.pm * 256 + wr * 64 + fr, col0 = u.pn * 256 + wc * 32 + 8 * fq;
#pragma unroll
        for (int ai = 0; ai < 2; ++ai)
#pragma unroll
            for (int m = 0; m < 4; ++m) { const int r = ai * 128 + wr * 64 + m * 16 + fr; const f32x4 t = *(const LAS f32x4*)(T2 + r * 4);
                const float inv = 1.0f / ((t[0] + t[1]) + (t[2] + t[3]));
#pragma unroll
                for (int bj = 0; bj < 2; ++bj) *(u32x4*)(PX + (size_t)(row0 + ai * 128 + m * 16) * 1024 + col0 + bj * 128) = pack8(acc[ai][bj][m][0] * inv, acc[ai][bj][m][1] * inv); }
        LDS_WAIT(); __builtin_amdgcn_s_barrier();
    }
};
struct SchedKVmem {
    int G, c; const char* MEMB; const char* W;
    DI bool next(int i, pg8::Unit& u) const { const int L = i * G + c; if (L >= 192) return false;
        if (L < 96) { const int b = L >> 4, pn = L & 15; u.pm = b; u.pn = pn; u.aux = 0; u.A = MEMB + (size_t)b * 256 * 4096 * 2; u.B = W + (size_t)pn * 256 * 4096 * 2; }
        else { const int l = L - 96, b = l >> 4, pmw = l & 15; u.pm = pmw; u.pn = 0; u.aux = 1 + b; u.A = W + (size_t)(4096 + pmw * 256) * 4096 * 2; u.B = MEMB + (size_t)b * 256 * 4096 * 2; }
        return true; } };
struct SchedXS {
    int G, c; const char* QX; const char* KMEM;
    DI bool next(int i, pg8::Unit& u) const { const int L = i * G + c; if (L >= 256) return false; const int pm = L >> 2, h = L & 3;
        u.pm = pm; u.pn = h; u.aux = 0; u.A = QX + (size_t)pm * 256 * 4096 * 2 + h * 1024 * 2; u.B = KMEM + (size_t)seq_of_pm(pm) * 256 * 4096 * 2 + h * 1024 * 2; return true; } };
struct SchedXO {
    int G, c; const char* PX; const char* VT;
    DI bool next(int i, pg8::Unit& u) const { const int L = i * G + c; if (L >= 1024) return false; const int pm = L >> 4, pn = L & 15;
        u.pm = pm; u.pn = pn; u.aux = 0; u.A = PX + (size_t)pm * 256 * 1024 * 2 + (pn >> 2) * 256 * 2; u.B = VT + (size_t)seq_of_pm(pm) * (4096 * 256 * 2) + (size_t)pn * 256 * 256 * 2; return true; } };

struct Frame {
    LAS unsigned char* lds; volatile LAS unsigned* MISC; gu32* ctl;
    int tid, lane, wave, G, vcu;
    unsigned char* ws;
};
constexpr int TAB_OFF = MISC_OFF + 512;
DI const float* in_ptr(const Frame& F, int i) {
    const LAS unsigned* t = (const LAS unsigned*)(F.lds + TAB_OFF) + 2 * i;
    const unsigned lo = __builtin_amdgcn_readfirstlane(t[0]), hi = __builtin_amdgcn_readfirstlane(t[1]);
    return (const float*)(const GAS float*)(((unsigned long long)hi << 32) | lo);
}

struct MapId { static DI int map(int n) { return n; } };
struct MapWin { static DI int map(int n) { return n < 1600 ? n : (n < 7744 ? n + 192 : (n < 7776 ? n - 7744 + 1600 : n + 160)); } };
struct MapUq { static DI int map(int n) { const int h = n / 192, w = n - h * 192; if (w < 128) return n; const int i = w - 128; return h * 192 + 128 + (i < 32 ? 2 * i : 2 * (i - 32) + 1); } };
template <class Map>
DI void tr_item(const float* W, int K, int N, bf16* WT, LAS float* scr, int item, int lane, const float* kgain, float scale) {
    const int nblk = N / 32, kb = item / nblk, nb = item - kb * nblk, k0 = 64 * kb, n0 = 32 * nb;
    float w[32];
#pragma unroll
    for (int i = 0; i < 32; ++i) { const int kk = 2 * i + (lane >> 5); w[i] = W[(size_t)(k0 + kk) * N + n0 + (lane & 31)]; }
#pragma unroll
    for (int i = 0; i < 32; ++i) { const int kk = 2 * i + (lane >> 5); const float g = kgain ? kgain[k0 + kk] * scale : scale; scr[kk * 33 + (lane & 31)] = w[i] * g; }
    LDS_WAIT(); asm volatile("" ::: "memory");
    const int c = lane & 7;
#pragma unroll
    for (int j = 0; j < 4; ++j) { const int n = (lane >> 3) + 8 * j; const LAS float* s = scr + (8 * c) * 33 + n;
        u32x4 o; o.x = pk2(s[0 * 33], s[1 * 33]); o.y = pk2(s[2 * 33], s[3 * 33]); o.z = pk2(s[4 * 33], s[5 * 33]); o.w = pk2(s[6 * 33], s[7 * 33]);
        *(GAS u32x4*)(WT + (size_t)Map::map(n0 + n) * K + k0 + 8 * c) = o; }
    LDS_WAIT(); asm volatile("" ::: "memory");
}
template <bool OUT_F32>
DI void ln_row(const float* src, const float* g, const float* b, void* dst, int lane) {
    const GAS f32x4* xr = (const GAS f32x4*)src + lane;
    f32x4 v[16]; float s = 0.f;
#pragma unroll
    for (int j = 0; j < 16; ++j) { v[j] = xr[64 * j]; s += (v[j].x + v[j].y) + (v[j].z + v[j].w); }
    const float mean = wave_sum(s) * (1.f / 4096.f); float s2 = 0.f;
#pragma unroll
    for (int j = 0; j < 16; ++j) { v[j] = v[j] - mean; s2 += (v[j].x * v[j].x + v[j].y * v[j].y) + (v[j].z * v[j].z + v[j].w * v[j].w); }
    const float rstd = 1.f / sqrtf(wave_sum(s2) * (1.f / 4096.f) + LN_EPS);
#pragma unroll
    for (int j = 0; j < 16; ++j) { const f32x4 gg = ((const GAS f32x4*)g)[lane + 64 * j], bb = ((const GAS f32x4*)b)[lane + 64 * j]; const f32x4 y = v[j] * rstd * gg + bb;
        if (OUT_F32) ((GAS f32x4*)dst)[lane + 64 * j] = y;
        else { u32x2 o; o.x = pk2(y.x, y.y); o.y = pk2(y.z, y.w); ((GAS u32x2*)dst)[lane + 64 * j] = o; } }
}

namespace att {
constexpr int NW = 8, QBLK = 32, KVBLK = 64;
constexpr int LDQ = 3072, LDKV = 4096, LDKR = 64, LDO = 2048;
constexpr int SHM_V = KVBLK * 128 * 2, SHM_K = KVBLK * 128 * 2, SHM_KR = KVBLK * 64 * 2;
constexpr int OFF_V = 0, OFF_K = 2 * SHM_V, OFF_KR = OFF_K + 2 * SHM_K, OFF_WS = OFF_KR + 2 * SHM_KR, OFF_QX = OFF_WS + NW * 64 * 4, LDS_BYTES = OFF_QX + NW * 8192;
static_assert(LDS_BYTES <= RING_BYTES, "attention LDS");
constexpr float THRL = 11.5f;
constexpr int SDEPTH = 1;
#define KSWZ(row, colB) ((row) * 256 + ((colB) ^ (((row) & 7) << 4)))
#define SBAR() __builtin_amdgcn_sched_barrier(0)
DI int crow(int r, int hi) { return (r & 3) + 8 * (r >> 2) + 4 * hi; }
DI void partialSM(f32x16& p0, f32x16& p1, float& m_reg, float& mn, float& alpha) {
    float pmax = p0[0];
#pragma unroll
    for (int r = 1; r < 16; ++r) pmax = fmaxf(pmax, p0[r]);
#pragma unroll
    for (int r = 0; r < 16; ++r) pmax = fmaxf(pmax, p1[r]);
    { auto rr = __builtin_amdgcn_permlane32_swap(__float_as_uint(pmax), __float_as_uint(pmax), false, false); pmax = fmaxf(__uint_as_float(rr[0]), __uint_as_float(rr[1])); }
    if (__builtin_expect(__all(pmax - m_reg <= THRL), 1)) { mn = m_reg; alpha = 1.f; }
    else { mn = fmaxf(m_reg, pmax); alpha = fexp2(m_reg - mn); m_reg = mn; }
#pragma unroll
    for (int r = 0; r < 16; ++r) p0[r] = p0[r] - mn;
#pragma unroll
    for (int r = 0; r < 16; ++r) p1[r] = p1[r] - mn;
#pragma unroll
    for (int r = 0; r < 16; ++r) p0[r] = fexp2(p0[r]);
}
DI void finishSM(f32x16& p0, f32x16& p1, float alpha, float& l_reg, bf16x8& pa0, bf16x8& pa1, bf16x8& pa2, bf16x8& pa3) {
#pragma unroll
    for (int r = 0; r < 16; ++r) p1[r] = fexp2(p1[r]);
    float ps = 0;
#pragma unroll
    for (int r = 0; r < 16; ++r) ps += p0[r];
#pragma unroll
    for (int r = 0; r < 16; ++r) ps += p1[r];
    { auto rr = __builtin_amdgcn_permlane32_swap(__float_as_uint(ps), __float_as_uint(ps), false, false); ps = __uint_as_float(rr[0]) + __uint_as_float(rr[1]); }
    l_reg = l_reg * alpha + ps;
#define PK4(P, BASE, OUT) do { unsigned a0 = pk2(P[BASE + 0], P[BASE + 1]), a1 = pk2(P[BASE + 2], P[BASE + 3]);   \
    unsigned b0 = pk2(P[BASE + 4], P[BASE + 5]), b1 = pk2(P[BASE + 6], P[BASE + 7]);                              \
    auto r0 = __builtin_amdgcn_permlane32_swap(a0, b0, false, false); auto r1 = __builtin_amdgcn_permlane32_swap(a1, b1, false, false); \
    u32x4 w = {r0[0], r1[0], r0[1], r1[1]}; OUT = __builtin_bit_cast(bf16x8, w); } while (0)
    PK4(p0, 0, pa0); PK4(p0, 8, pa1); PK4(p1, 0, pa2); PK4(p1, 8, pa3);
#undef PK4
}
DI void qkt(f32x16& p0, f32x16& p1, const char* Ks, const char* KRs, const bf16x8* qr, const char* qxl, int r32, int hi) {
#pragma unroll
    for (int r = 0; r < 16; ++r) { p0[r] = 0.f; p1[r] = 0.f; }
    const int sw = (r32 >> 1) & 7;
#pragma unroll
    for (int d0 = 0; d0 < 8; ++d0) { const int cb = (d0 * 16 + hi * 8) * 2;
        const bf16x8 b0 = *reinterpret_cast<const bf16x8*>(Ks + KSWZ(r32, cb));
        const bf16x8 b1 = *reinterpret_cast<const bf16x8*>(Ks + KSWZ(32 + r32, cb));
        const bf16x8 qf = d0 < 4 ? qr[d0 & 3] : *reinterpret_cast<const bf16x8*>(qxl + 4096 + r32 * 128 + (((2 * (d0 & 3) + hi) ^ sw) << 4));
        p0 = __builtin_amdgcn_mfma_f32_32x32x16_bf16(b0, qf, p0, 0, 0, 0);
        p1 = __builtin_amdgcn_mfma_f32_32x32x16_bf16(b1, qf, p1, 0, 0, 0); }
#pragma unroll
    for (int d0 = 0; d0 < 4; ++d0) { const int ch = (2 * d0 + hi) ^ sw;
        const bf16x8 b0 = *reinterpret_cast<const bf16x8*>(KRs + r32 * 128 + ch * 16);
        const bf16x8 b1 = *reinterpret_cast<const bf16x8*>(KRs + (32 + r32) * 128 + ch * 16);
        const bf16x8 qx = *reinterpret_cast<const bf16x8*>(qxl + r32 * 128 + ch * 16);
        p0 = __builtin_amdgcn_mfma_f32_32x32x16_bf16(b0, qx, p0, 0, 0, 0);
        p1 = __builtin_amdgcn_mfma_f32_32x32x16_bf16(b1, qx, p1, 0, 0, 0); }
}
DI int v_st(int k, int c) { const int kk = (k & ~0xC) | ((k & 4) << 1) | ((k & 8) >> 1); return ((kk >> 3) * 4 + (c >> 5)) * 512 + ((kk & 7) * 32 + (c & 31)) * 2; }
DI int v_rd_base(int lane) { return ((lane & 3) << 3) | (((lane >> 2) & 3) << 6) | (((lane >> 4) & 1) << 5) | (((lane >> 5) & 1) << 8); }
constexpr int v_rd_off(int d0, int ks, int half) { return d0 * 512 + ks * 4096 + half * 2048; }
template <int OFF> DI s16x4 tr_read(int vb) { s16x4 r; asm volatile("ds_read_b64_tr_b16 %0, %1 offset:%2" : "=&v"(r) : "v"(vb), "i"(OFF) : "memory"); return r; }
template <int D0> DI void pv_one(f32x16& od, int vb, bf16x8 pa0, bf16x8 pa1, bf16x8 pa2, bf16x8 pa3) {
    const s16x4 l0 = tr_read<v_rd_off(D0, 0, 0)>(vb), h0 = tr_read<v_rd_off(D0, 0, 1)>(vb), l1 = tr_read<v_rd_off(D0, 1, 0)>(vb), h1 = tr_read<v_rd_off(D0, 1, 1)>(vb);
    const s16x4 l2 = tr_read<v_rd_off(D0, 2, 0)>(vb), h2 = tr_read<v_rd_off(D0, 2, 1)>(vb), l3 = tr_read<v_rd_off(D0, 3, 0)>(vb), h3 = tr_read<v_rd_off(D0, 3, 1)>(vb);
    asm volatile("s_waitcnt lgkmcnt(0)" ::: "memory"); SBAR();
#define PK(L, H) (bf16x8){L[0], L[1], L[2], L[3], H[0], H[1], H[2], H[3]}
    od = __builtin_amdgcn_mfma_f32_32x32x16_bf16(pa0, PK(l0, h0), od, 0, 0, 0);
    od = __builtin_amdgcn_mfma_f32_32x32x16_bf16(pa1, PK(l1, h1), od, 0, 0, 0);
    od = __builtin_amdgcn_mfma_f32_32x32x16_bf16(pa2, PK(l2, h2), od, 0, 0, 0);
    od = __builtin_amdgcn_mfma_f32_32x32x16_bf16(pa3, PK(l3, h3), od, 0, 0, 0);
#undef PK
}
DI void pv_d0(f32x16* o, int vb, bf16x8 pa0, bf16x8 pa1, bf16x8 pa2, bf16x8 pa3) {
    pv_one<0>(o[0], vb, pa0, pa1, pa2, pa3); pv_one<1>(o[1], vb, pa0, pa1, pa2, pa3); pv_one<2>(o[2], vb, pa0, pa1, pa2, pa3); pv_one<3>(o[3], vb, pa0, pa1, pa2, pa3);
}
DI void attn_unit(const bf16* __restrict__ Qb, const bf16* __restrict__ Kh, const bf16* __restrict__ Vh, const bf16* __restrict__ KRh, bf16* __restrict__ Ob, int seq, char* lds) {
    int tid_ = threadIdx.x; asm volatile("" : "+v"(tid_));
    const int tid = tid_, wid = tid >> 6, lane = tid & 63, r32 = lane & 31, hi = lane >> 5;
    char* V_lds = lds + OFF_V; char* K_lds = lds + OFF_K; char* KR_lds = lds + OFF_KR;
    float* wsf = (float*)(lds + OFF_WS) + wid * 64; float* li_l = wsf; float* al_l = wsf + 32;
    float m_reg = -1e30f, l_reg = 0; f32x16 o[4]; bf16x8 qr[4];
    char* qxl = lds + OFF_QX + wid * 8192;
#pragma unroll
    for (int d = 0; d < 4; ++d)
#pragma unroll
        for (int r = 0; r < 16; ++r) o[d][r] = 0.f;
    const bf16* Qw = Qb + (long)(wid * QBLK + r32) * LDQ + hi * 8;
#pragma unroll
    for (int d0 = 0; d0 < 4; ++d0) qr[d0] = *reinterpret_cast<const bf16x8*>(Qw + d0 * 16);
#pragma unroll
    for (int d0 = 0; d0 < 4; ++d0) *reinterpret_cast<bf16x8*>(qxl + 4096 + r32 * 128 + (((2 * d0 + hi) ^ ((r32 >> 1) & 7)) << 4)) = *reinterpret_cast<const bf16x8*>(Qw + 64 + d0 * 16);
#pragma unroll
    for (int d0 = 0; d0 < 4; ++d0) *reinterpret_cast<bf16x8*>(qxl + r32 * 128 + (((2 * d0 + hi) ^ ((r32 >> 1) & 7)) << 4)) = *reinterpret_cast<const bf16x8*>(Qw + 128 + d0 * 16);
    const int sr = tid >> 4, sc = (tid & 15) * 8, vst0 = v_st(sr, sc), vst1 = v_st(32 + sr, sc);
    const int krr = tid >> 3, krc = tid & 7, krst = krr * 128 + ((krc ^ ((krr >> 1) & 7)) << 4);
    const int vb0 = (int)(uintptr_t)V_lds + v_rd_base(lane);
    struct { bf16x8 vs0, vs1, ks0, ks1, kr; } sr_[SDEPTH];
#define SLOAD(i, k0) do { sr_[i].vs0 = *reinterpret_cast<const bf16x8*>(&Vh[(long)((k0) + sr) * LDKV + sc]); sr_[i].vs1 = *reinterpret_cast<const bf16x8*>(&Vh[(long)((k0) + 32 + sr) * LDKV + sc]); \
    sr_[i].ks0 = *reinterpret_cast<const bf16x8*>(&Kh[(long)((k0) + sr) * LDKV + sc]); sr_[i].ks1 = *reinterpret_cast<const bf16x8*>(&Kh[(long)((k0) + 32 + sr) * LDKV + sc]); \
    sr_[i].kr = *reinterpret_cast<const bf16x8*>(&KRh[(long)((k0) + krr) * LDKR + krc * 8]); } while (0)
#define SWRITE(b, i) do { *(bf16x8*)(V_lds + (b) * SHM_V + vst0) = sr_[i].vs0; *(bf16x8*)(V_lds + (b) * SHM_V + vst1) = sr_[i].vs1; const int kc = sc * 2; \
    *(bf16x8*)(K_lds + (b) * SHM_K + KSWZ(sr, kc)) = sr_[i].ks0; *(bf16x8*)(K_lds + (b) * SHM_K + KSWZ(32 + sr, kc)) = sr_[i].ks1; \
    *(bf16x8*)(KR_lds + (b) * SHM_KR + krst) = sr_[i].kr; } while (0)
#define SWAIT() do { if constexpr (SDEPTH == 2) asm volatile("s_waitcnt vmcnt(5)" ::: "memory"); else asm volatile("s_waitcnt vmcnt(0)" ::: "memory"); } while (0)
#define RESC(a) do { if (__any((a) < 1.f)) { if (hi == 0) al_l[r32] = (a); asm volatile("s_waitcnt lgkmcnt(0)" ::: "memory"); \
    _Pragma("unroll") for (int d = 0; d < 4; ++d) _Pragma("unroll") for (int r = 0; r < 16; ++r) o[d][r] *= al_l[crow(r, hi)]; } } while (0)
    f32x16 pA0, pA1, pB0, pB1; float mnA, mnB, alA, alB; bf16x8 pa0, pa1, pa2, pa3; const int NT = seq / KVBLK;
    constexpr int SE = 0, SO = SDEPTH - 1;
    SLOAD(SE, 0); asm volatile("s_waitcnt vmcnt(0)" ::: "memory"); SWRITE(0, SE); __syncthreads();
    qkt(pA0, pA1, K_lds, KR_lds, qr, qxl, r32, hi); partialSM(pA0, pA1, m_reg, mnA, alA);
    SLOAD(SO, KVBLK); if constexpr (SDEPTH == 2) { if (2 < NT) SLOAD(SE, 2 * KVBLK); }
    SWAIT(); SWRITE(1, SO); __syncthreads();
    for (int j = 1; j + 1 < NT; j += 2) {
        SBAR(); qkt(pB0, pB1, K_lds + SHM_K, KR_lds + SHM_KR, qr, qxl, r32, hi);
        finishSM(pA0, pA1, alA, l_reg, pa0, pa1, pa2, pa3); SBAR();
        SLOAD(SO, (j + SDEPTH) * KVBLK); SBAR();
        pv_d0(o, vb0, pa0, pa1, pa2, pa3); partialSM(pB0, pB1, m_reg, mnB, alB);
        __syncthreads(); SWAIT(); SWRITE(0, SE);
        RESC(alB); __syncthreads();
        SBAR(); qkt(pA0, pA1, K_lds, KR_lds, qr, qxl, r32, hi);
        finishSM(pB0, pB1, alB, l_reg, pa0, pa1, pa2, pa3); SBAR();
        if (SDEPTH == 1 || j + 3 < NT) SLOAD(SE, (j + 1 + SDEPTH) * KVBLK); SBAR();
        pv_d0(o, vb0 + SHM_V, pa0, pa1, pa2, pa3); partialSM(pA0, pA1, m_reg, mnA, alA);
        __syncthreads(); SWAIT(); SWRITE(1, SO);
        RESC(alA); __syncthreads();
    }
    SBAR(); qkt(pB0, pB1, K_lds + SHM_K, KR_lds + SHM_KR, qr, qxl, r32, hi);
    finishSM(pA0, pA1, alA, l_reg, pa0, pa1, pa2, pa3); SBAR();
    pv_d0(o, vb0, pa0, pa1, pa2, pa3); partialSM(pB0, pB1, m_reg, mnB, alB);
    __syncthreads(); RESC(alB);
    finishSM(pB0, pB1, alB, l_reg, pa0, pa1, pa2, pa3); SBAR();
    pv_d0(o, vb0 + SHM_V, pa0, pa1, pa2, pa3);
    if (hi == 0) li_l[r32] = l_reg; asm volatile("s_waitcnt lgkmcnt(0)" ::: "memory");
    float rli[16];
#pragma unroll
    for (int r = 0; r < 16; ++r) rli[r] = frcp(li_l[crow(r, hi)]);
    bf16* Ow = Ob + (long)(wid * QBLK) * LDO;
#pragma unroll
    for (int r = 0; r < 16; ++r) { const int orow = crow(r, hi);
#pragma unroll
        for (int d0 = 0; d0 < 4; ++d0) Ow[(long)orow * LDO + d0 * 32 + r32] = (bf16)(pk2(o[d0][r] * rli[r], 0.f) & 0xffffu); }
    __syncthreads();
#undef SLOAD
#undef SWRITE
#undef SWAIT
#undef RESC
}
}

namespace gla {
constexpr int RS = 544, RSV = 288, RSA = 144;
constexpr int OFF_QD = 0, OFF_KI = 64 * RS, OFF_V = 2 * 64 * RS, OFF_AI = OFF_V + 64 * RSV, OFF_EL = OFF_AI + 64 * RSA, LDS_BYTES = OFF_EL + 1024;
static_assert(LDS_BYTES <= RING_BYTES, "gla LDS");
DI s16x4 trr(LAS const unsigned char* p) { return __builtin_bit_cast(s16x4, __builtin_amdgcn_ds_read_tr16_b64_v4i16((LAS v4i16_t*)p)); }
DI bf16x8 cat8(s16x4 a, s16x4 b) { return (bf16x8){a[0], a[1], a[2], a[3], b[0], b[1], b[2], b[3]}; }
struct Raw { u32x4 q[4], k[4]; f32x4 c[4][2]; u32x2 v[4]; };
DI void load_raw(Raw& R, const bf16* P, const float* CUMd, int r0, int h, int slice, int tg, int col8, int dv4) {
#pragma unroll
    for (int i = 0; i < 4; ++i) { const size_t row = (size_t)(r0 + 4 * tg + i);
        R.q[i] = *(const u32x4*)(P + row * NP + PC_GQ + h * 256 + 8 * col8);
        R.k[i] = *(const u32x4*)(P + row * NP + PC_GK + h * 256 + 8 * col8);
        R.c[i][0] = *(const f32x4*)(CUMd + row * 1024 + h * 256 + 8 * col8); R.c[i][1] = *(const f32x4*)(CUMd + row * 1024 + h * 256 + 8 * col8 + 4);
        R.v[i] = *(const u32x2*)(P + row * NP + PC_GV + h * 512 + slice * 128 + 4 * dv4); }
}
DI void gla_item(const bf16* __restrict__ P, const float* __restrict__ CUM, bf16* __restrict__ OUTF, bf16* __restrict__ OUTB, int item, LAS unsigned char* lds) {
    int tid_ = threadIdx.x; asm volatile("" : "+v"(tid_));
    const int tid = tid_, w = __builtin_amdgcn_readfirstlane(tid >> 6), lane = tid & 63, l15 = lane & 15, g = lane >> 4, q4 = (lane >> 2) & 3, p4 = lane & 3;
    const int xcd = item & 7, jj = item >> 3, slice = jj & 3, grp = (jj >> 2) * 8 + xcd, seq = grp >> 3, h = (grp >> 1) & 3, dir = grp & 1;
    const int row0 = seq < 4 ? seq * 2048 : 8192 + (seq - 4) * 4096, nch = seq < 4 ? 32 : 64;
    const float* CUMd = CUM + (size_t)dir * M * 1024; bf16* OUT = dir ? OUTB : OUTF;
    const int col8 = tid & 31, tg = tid >> 5, dv4 = tid & 31;
    f32x4 S[16];
#pragma unroll
    for (int i = 0; i < 16; ++i) S[i] = (f32x4){0.f, 0.f, 0.f, 0.f};
    Raw R;
    load_raw(R, P, CUMd, row0 + 64 * (dir ? nch - 1 : 0), h, slice, tg, col8, dv4);
    for (int n = 0; n < nch; ++n) {
        const int ch = dir ? nch - 1 - n : n, r0 = row0 + 64 * ch;
        {
#pragma unroll
            for (int i = 0; i < 4; ++i) {
                f32x4 q0, q1, k0, k1; unpack8(R.q[i], q0, q1); unpack8(R.k[i], k0, k1);
                f32x4 e0, e1, f0, f1;
#pragma unroll
                for (int j = 0; j < 4; ++j) { e0[j] = fexp2(R.c[i][0][j] * LOG2E); e1[j] = fexp2(R.c[i][1][j] * LOG2E); f0[j] = fexp2(-R.c[i][0][j] * LOG2E); f1[j] = fexp2(-R.c[i][1][j] * LOG2E); }
                const int tok = 4 * tg + i;
                *(LAS u32x4*)(lds + OFF_QD + tok * RS + col8 * 16) = pack8(q0 * e0 * 0.0625f, q1 * e1 * 0.0625f);
                *(LAS u32x4*)(lds + OFF_KI + tok * RS + col8 * 16) = pack8(k0 * f0, k1 * f1);
                *(LAS u32x2*)(lds + OFF_V + tok * RSV + dv4 * 8) = R.v[i];
            }
            if (tg == (dir ? 0 : 15)) { f32x4 a, b;
                const f32x4 c0 = dir ? R.c[0][0] : R.c[3][0], c1 = dir ? R.c[0][1] : R.c[3][1];
#pragma unroll
                for (int j = 0; j < 4; ++j) { a[j] = fexp2(c0[j] * LOG2E); b[j] = fexp2(c1[j] * LOG2E); }
                *(LAS f32x4*)(lds + OFF_EL + col8 * 32) = a; *(LAS f32x4*)(lds + OFF_EL + col8 * 32 + 16) = b; }
        }
        LDS_WAIT(); __syncthreads();
        if (n + 1 < nch) { const int ch2 = dir ? nch - 2 - n : n + 1; load_raw(R, P, CUMd, row0 + 64 * ch2, h, slice, tg, col8, dv4); }
        {
            const int ci = w >> 1, ji0 = 2 * (w & 1);
            f32x4 a0 = {0.f, 0.f, 0.f, 0.f}, a1 = {0.f, 0.f, 0.f, 0.f};
#pragma unroll
            for (int s = 0; s < 8; ++s) {
                const bf16x8 qa = *(const LAS bf16x8*)(lds + OFF_QD + (16 * ci + l15) * RS + (32 * s + 8 * g) * 2);
                const bf16x8 kb0 = *(const LAS bf16x8*)(lds + OFF_KI + (16 * ji0 + l15) * RS + (32 * s + 8 * g) * 2);
                const bf16x8 kb1 = *(const LAS bf16x8*)(lds + OFF_KI + (16 * ji0 + 16 + l15) * RS + (32 * s + 8 * g) * 2);
                a0 = __builtin_amdgcn_mfma_f32_16x16x32_bf16(qa, kb0, a0, 0, 0, 0);
                a1 = __builtin_amdgcn_mfma_f32_16x16x32_bf16(qa, kb1, a1, 0, 0, 0);
            }
#pragma unroll
            for (int r = 0; r < 4; ++r) { const int c = 16 * ci + 4 * g + r, j0 = 16 * ji0 + l15, j1 = j0 + 16;
                const bool k0 = dir ? (j0 >= c) : (j0 <= c), k1 = dir ? (j1 >= c) : (j1 <= c);
                *(LAS bf16*)(lds + OFF_AI + c * RSA + j0 * 2) = (bf16)(pk2(k0 ? a0[r] : 0.f, 0.f) & 0xffffu);
                *(LAS bf16*)(lds + OFF_AI + c * RSA + j1 * 2) = (bf16)(pk2(k1 ? a1[r] : 0.f, 0.f) & 0xffffu); }
        }
        f32x4 o[4];
#pragma unroll
        for (int ci = 0; ci < 4; ++ci) o[ci] = (f32x4){0.f, 0.f, 0.f, 0.f};
#pragma unroll
        for (int i = 0; i < 8; ++i) {
            u32x4 sb; sb.x = pk2(S[2 * i][0], S[2 * i][1]); sb.y = pk2(S[2 * i][2], S[2 * i][3]); sb.z = pk2(S[2 * i + 1][0], S[2 * i + 1][1]); sb.w = pk2(S[2 * i + 1][2], S[2 * i + 1][3]);
            const bf16x8 sfrag = __builtin_bit_cast(bf16x8, sb);
#pragma unroll
            for (int ci = 0; ci < 4; ++ci) {
                const s16x4 lo = *(const LAS s16x4*)(lds + OFF_QD + (16 * ci + l15) * RS + (32 * i + 4 * g) * 2);
                const s16x4 hi = *(const LAS s16x4*)(lds + OFF_QD + (16 * ci + l15) * RS + (32 * i + 16 + 4 * g) * 2);
                o[ci] = __builtin_amdgcn_mfma_f32_16x16x32_bf16(cat8(lo, hi), sfrag, o[ci], 0, 0, 0);
            }
        }
        LDS_WAIT(); __syncthreads();
        bf16x8 vf[2];
#pragma unroll
        for (int s = 0; s < 2; ++s) {
            const s16x4 lo = trr(lds + OFF_V + (32 * s + 4 * g + q4) * RSV + (16 * w + 4 * p4) * 2);
            const s16x4 hi = trr(lds + OFF_V + (32 * s + 16 + 4 * g + q4) * RSV + (16 * w + 4 * p4) * 2);
            vf[s] = cat8(lo, hi);
        }
#pragma unroll
        for (int ci = 0; ci < 4; ++ci)
#pragma unroll
            for (int s = 0; s < 2; ++s) {
                const s16x4 lo = *(const LAS s16x4*)(lds + OFF_AI + (16 * ci + l15) * RSA + (32 * s + 4 * g) * 2);
                const s16x4 hi = *(const LAS s16x4*)(lds + OFF_AI + (16 * ci + l15) * RSA + (32 * s + 16 + 4 * g) * 2);
                o[ci] = __builtin_amdgcn_mfma_f32_16x16x32_bf16(cat8(lo, hi), vf[s], o[ci], 0, 0, 0);
            }
#pragma unroll
        for (int i = 0; i < 16; ++i) {
#pragma unroll
            for (int s = 0; s < 2; ++s) {
                const s16x4 lo = trr(lds + OFF_KI + (32 * s + 4 * g + q4) * RS + (16 * i + 4 * p4) * 2);
                const s16x4 hi = trr(lds + OFF_KI + (32 * s + 16 + 4 * g + q4) * RS + (16 * i + 4 * p4) * 2);
                S[i] = __builtin_amdgcn_mfma_f32_16x16x32_bf16(cat8(lo, hi), vf[s], S[i], 0, 0, 0);
            }
            const f32x4 el = *(const LAS f32x4*)(lds + OFF_EL + (16 * i + 4 * g) * 4);
            S[i] = S[i] * el;
        }
#pragma unroll
        for (int ci = 0; ci < 4; ++ci)
#pragma unroll
            for (int r = 0; r < 4; ++r) OUT[(size_t)(r0 + 16 * ci + 4 * g + r) * 2048 + h * 512 + slice * 128 + 16 * w + l15] = (bf16)(pk2(o[ci][r], 0.f) & 0xffffu);
        LDS_WAIT(); __syncthreads();
    }
}
}

struct Args { const float* in[29]; float* out; unsigned char* ws; };

__global__ void __launch_bounds__(512, 2) fwd_kernel(Args args) {
    extern __shared__ __attribute__((aligned(16))) unsigned char lds_raw[];
    Frame F;
    F.lds = (LAS unsigned char*)lds_raw;
    F.MISC = (volatile LAS unsigned*)(F.lds + MISC_OFF);
    F.tid = threadIdx.x; F.lane = F.tid & 63; F.wave = __builtin_amdgcn_readfirstlane(F.tid >> 6);
    F.G = gridDim.x; { const int bx = blockIdx.x; F.vcu = (F.G % 8 == 0) ? (bx % 8) * (F.G / 8) + bx / 8 : bx; }
    F.ws = args.ws; F.ctl = (gu32*)(args.ws + WS_CTL);
    unsigned char* ws = args.ws;
    for (int u = F.tid; u < (LDS_BYTES - MISC_OFF) / 4; u += 512) ((LAS unsigned*)(F.lds + MISC_OFF))[u] = 0u;
    __syncthreads();
    if (F.tid == 0) { LAS unsigned long long* tab = (LAS unsigned long long*)(F.lds + TAB_OFF);
#define TABW(i) tab[i] = (unsigned long long)args.in[i]
        TABW(0); TABW(1); TABW(2); TABW(3); TABW(4); TABW(5); TABW(6); TABW(7); TABW(8); TABW(9); TABW(10); TABW(11); TABW(12); TABW(13); TABW(14);
        TABW(15); TABW(16); TABW(17); TABW(18); TABW(19); TABW(20); TABW(21); TABW(22); TABW(23); TABW(24); TABW(25); TABW(26); TABW(27); TABW(28);
#undef TABW
    }
    LDS_WAIT(); __syncthreads();
#define INP(i) in_ptr(F, i)
    XcdBarrier bar = xcd_barrier_post((unsigned*)(F.ctl + CW_BAR), F.MISC + 8);
#define GRID_BAR() xcd_barrier(bar)
    const int gw = F.vcu * 8 + F.wave, NGW = F.G * 8;
    const int bid = (int)blockIdx.x;

#define W_uq ((bf16*)(ws + WS_WUQ))
#define W_ukv ((bf16*)(ws + WS_WUKV))
#define W_bra ((bf16*)(ws + WS_WBRA))
#define W_brb ((bf16*)(ws + WS_WBRB))
#define W_out ((bf16*)(ws + WS_WOUT))
#define W_xq ((bf16*)(ws + WS_WXQ))
#define W_xkv ((bf16*)(ws + WS_WXKV))
#define W_xo ((bf16*)(ws + WS_WXO))
#define W_1 ((bf16*)(ws + WS_W1))
#define W_2 ((bf16*)(ws + WS_W2))
#define W_in ((bf16*)(ws + WS_WIN))
#define H ((bf16*)(ws + WS_H))
#define P ((bf16*)(ws + WS_P))
#define MEMB ((bf16*)(ws + WS_MEMB))
#define cosT ((float*)(ws + WS_ROPE))
#define sinT ((float*)(ws + WS_ROPE) + 4096 * 32)
#define rstd_q ((float*)(ws + WS_RSTD))
#define rstd_kv ((float*)(ws + WS_RSTD) + M)
#define KR ((bf16*)(ws + WS_KR))
#define CUM ((float*)(ws + WS_CUM))
#define Q ((bf16*)(ws + WS_Q))
#define KV ((bf16*)(ws + WS_KV))
#define OMLA ((bf16*)(ws + WS_OMLA))
#define GLAF ((bf16*)(ws + WS_GLAF))
#define GLAB ((bf16*)(ws + WS_GLAB))
#define OGLA ((bf16*)(ws + WS_OGLA))
#define MERGED ((bf16*)(ws + WS_MERGED))
#define GATES ((bf16*)args.out)
#define Y (args.out)
#define QX ((bf16*)(ws + WS_QX))
#define KMEM ((bf16*)(ws + WS_KMEM))
#define VT ((bf16*)(ws + WS_VT))
#define PX ((bf16*)(ws + WS_PX))
#define OX ((bf16*)(ws + WS_OX))
#define HID ((bf16*)(ws + WS_HID))

    {
        LAS float* scr = (LAS float*)(F.lds + F.wave * 16384);
        constexpr int I_IN = 64 * 499, I_UQ = 16 * 96, I_UKV = 8 * 128, I_BR = 32 * 128, I_SQ = 64 * 128, I_XKV = 64 * 256, I_W1 = 64 * 512, I_W2 = 256 * 128;
        constexpr int NITEMS = I_IN + I_UQ + I_UKV + 2 * I_BR + 3 * I_SQ + I_XKV + I_W1 + I_W2;
        for (int it = gw; it < NITEMS; it += NGW) {
            int r = it;
            if (r < I_W1) { tr_item<MapId>(INP(25), 4096, 16384, W_1, scr, r, F.lane, nullptr, 1.f); continue; } r -= I_W1;
            if (r < I_W2) { tr_item<MapId>(INP(26), 16384, 4096, W_2, scr, r, F.lane, nullptr, 1.f); continue; } r -= I_W2;
            if (r < I_IN) { tr_item<MapWin>(INP(6), 4096, IN_TOTAL, W_in, scr, r, F.lane, nullptr, 1.f); continue; } r -= I_IN;
            if (r < I_XKV) { tr_item<MapId>(INP(21), 4096, 8192, W_xkv, scr, r, F.lane, nullptr, 1.f); continue; } r -= I_XKV;
            if (r < I_SQ) { tr_item<MapId>(INP(17), 4096, 4096, W_out, scr, r, F.lane, nullptr, 1.f); continue; } r -= I_SQ;
            if (r < I_SQ) { tr_item<MapId>(INP(20), 4096, 4096, W_xq, scr, r, F.lane, nullptr, CQ_XA); continue; } r -= I_SQ;
            if (r < I_SQ) { tr_item<MapId>(INP(22), 4096, 4096, W_xo, scr, r, F.lane, nullptr, 1.f); continue; } r -= I_SQ;
            if (r < I_BR) { tr_item<MapId>(INP(15), 2048, 4096, W_bra, scr, r, F.lane, nullptr, 1.f); continue; } r -= I_BR;
            if (r < I_BR) { tr_item<MapId>(INP(16), 2048, 4096, W_brb, scr, r, F.lane, nullptr, 1.f); continue; } r -= I_BR;
            if (r < I_UQ) { tr_item<MapUq>(INP(9), 1024, 3072, W_uq, scr, r, F.lane, INP(8), CQ_MLA); continue; } r -= I_UQ;
            tr_item<MapId>(INP(11), 512, 4096, W_ukv, scr, r, F.lane, INP(10), 1.f);
        }
        for (int m = gw; m < M; m += NGW) { const float* xr = m < 8192 ? INP(0) + (size_t)m * DM : INP(1) + (size_t)(m - 8192) * DM; ln_row<false>(xr, INP(4), INP(5), H + (size_t)m * DM, F.lane); }
        for (int m = gw; m < 1536; m += NGW) { const float* mr = m < 1024 ? INP(2) + (size_t)m * DM : INP(3) + (size_t)(m - 1024) * DM;
#pragma unroll
            for (int j = 0; j < 16; ++j) { const f32x4 v = ((const GAS f32x4*)mr)[F.lane + 64 * j]; u32x2 o; o.x = pk2(v.x, v.y); o.y = pk2(v.z, v.w); ((GAS u32x2*)(MEMB + (size_t)m * DM))[F.lane + 64 * j] = o; } }
        for (int e = bid * 512 + F.tid; e < 4096 * 32; e += F.G * 512) { const int pos = e >> 5, i = e & 31;
            const float inv = fexp2(-(float)i * (13.287712379549449f / 32.f));
            const double rev = (double)pos * (double)inv * 0.15915494309189535; const float fr = (float)(rev - floor(rev));
            cosT[e] = __builtin_amdgcn_cosf(fr); sinT[e] = __builtin_amdgcn_sinf(fr); }
    }
    GRID_BAR();

    { pg8::SchedStd S; S.init(64, 63, F.G, bid, H, 4096, W_in, 4096);
      pg8::EpiRow8<OpG1> E{{P, GATES, INP(7)}};
      pg8::gemm_phase<pg8::EpiRow8<OpG1>, pg8::SchedStd, true>(F.lds, 4096, 4096, 4096, S, E); }
    GRID_BAR();

    {
        for (int m = gw; m < M; m += NGW) {
            const bf16* p = P + (size_t)m * NP; f32x4 a, b; float sq = 0.f, sk = 0.f;
            unpack8(*(const u32x4*)(p + PC_CQ + F.lane * 8), a, b); sq += (a[0] * a[0] + a[1] * a[1]) + (a[2] * a[2] + a[3] * a[3]) + (b[0] * b[0] + b[1] * b[1]) + (b[2] * b[2] + b[3] * b[3]);
            unpack8(*(const u32x4*)(p + PC_CQ + 512 + F.lane * 8), a, b); sq += (a[0] * a[0] + a[1] * a[1]) + (a[2] * a[2] + a[3] * a[3]) + (b[0] * b[0] + b[1] * b[1]) + (b[2] * b[2] + b[3] * b[3]);
            unpack8(*(const u32x4*)(p + PC_CKV + F.lane * 8), a, b); sk += (a[0] * a[0] + a[1] * a[1]) + (a[2] * a[2] + a[3] * a[3]) + (b[0] * b[0] + b[1] * b[1]) + (b[2] * b[2] + b[3] * b[3]);
            sq = wave_sum(sq); sk = wave_sum(sk);
            if (F.lane == 0) { rstd_q[m] = 1.f / sqrtf(sq * (1.f / 1024.f) + RMS_EPS); rstd_kv[m] = 1.f / sqrtf(sk * (1.f / 512.f) + RMS_EPS); }
            if (F.lane < 32) { const float x1 = bf1(p[PC_KROPE + F.lane]), x2 = bf1(p[PC_KROPE + 32 + F.lane]); const int pos = seq_pos(m);
                const float c = cosT[pos * 32 + F.lane], s = sinT[pos * 32 + F.lane];
                ((unsigned*)(KR + (size_t)m * 64))[F.lane] = pk2(x1 * c - x2 * s, x2 * c + x1 * s); }
        }
        LAS float* lrs = (LAS float*)F.lds;
        const float* w2 = INP(12); const float* gb = INP(13);
        for (int ch = bid; ch < M / 64; ch += F.G) {
            const int m0 = ch * 64;
            for (int idx = F.tid; idx < 64 * 32; idx += 512) lrs[idx] = bf1(P[(size_t)(m0 + (idx >> 5)) * NP + PC_GLR + (idx & 31)]);
            LDS_WAIT(); __syncthreads();
#pragma unroll
            for (int cc = 0; cc < 4; ++cc) {
                const int dir = cc >> 1, key = (F.tid + 512 * cc) & 1023;
                float wv[16];
#pragma unroll
                for (int r = 0; r < 16; ++r) wv[r] = w2[(dir * 16 + r) * 1024 + key];
                const float gbv = gb[dir * 1024 + key]; float run = 0.f;
                for (int tt = 0; tt < 64; ++tt) { const int t = dir ? 63 - tt : tt;
                    float x = gbv;
#pragma unroll
                    for (int r4 = 0; r4 < 4; ++r4) { const f32x4 l = *(const LAS f32x4*)(lrs + t * 32 + dir * 16 + 4 * r4); x += l[0] * wv[4 * r4] + l[1] * wv[4 * r4 + 1] + l[2] * wv[4 * r4 + 2] + l[3] * wv[4 * r4 + 3]; }
                    const float la = (fminf(x, 0.f) - __logf(1.f + __expf(-fabsf(x)))) * 0.0625f;
                    run += la; CUM[((size_t)dir * M + m0 + t) * 1024 + key] = run; }
            }
            LDS_WAIT(); __syncthreads();
        }
    }
    GRID_BAR();

    { pg8::SchedStd S; S.init(64, 12, F.G, bid, P + PC_CQ, NP, W_uq, 1024);
      pg8::EpiRow8<OpQ> E{{Q, rstd_q, cosT, sinT}};
      pg8::gemm_phase<pg8::EpiRow8<OpQ>, pg8::SchedStd, true>(F.lds, 1024, NP, 1024, S, E); }
    { pg8::SchedStd S; S.init(64, 16, F.G, bid, P + PC_CKV, NP, W_ukv, 512);
      pg8::EpiRow8<OpKV> E{{KV, rstd_kv}};
      pg8::gemm_phase<pg8::EpiRow8<OpKV>, pg8::SchedStd, true>(F.lds, 512, NP, 512, S, E); }
    GRID_BAR();

    if (bid < 192) gla::gla_item(P, CUM, GLAF, GLAB, bid, F.lds);
    for (;;) {
        if (F.tid == 0) F.MISC[16] = __hip_atomic_fetch_add((unsigned*)(F.ctl + CW_QUEUE), 1u, RLX_AGENT);
        LDS_WAIT(); __syncthreads();
        const int u = (int)F.MISC[16];
        __syncthreads();
        if (u >= 1024) break;
        int seq, h, qb, row0, S_;
        if (u < 512) { const int pair = u >> 4; qb = u & 15; seq = 4 + (pair >> 4); h = pair & 15; row0 = 8192 + (seq - 4) * 4096; S_ = 4096; }
        else { const int v = u - 512, pair = v >> 3; qb = v & 7; seq = pair >> 4; h = pair & 15; row0 = seq * 2048; S_ = 2048; }
        att::attn_unit(Q + (size_t)(row0 + qb * 256) * 3072 + h * 192, KV + (size_t)row0 * 4096 + h * 256, KV + (size_t)row0 * 4096 + h * 256 + 128, KR + (size_t)row0 * 64,
                       OMLA + (size_t)(row0 + qb * 256) * 2048 + h * 128, S_, (char*)lds_raw);
    }
    GRID_BAR();

    {
        const float* gn = INP(14);
        for (int m = gw; m < M; m += NGW) {
#pragma unroll
            for (int h = 0; h < 4; ++h) { const size_t base = (size_t)m * 2048 + h * 512 + F.lane * 8;
                f32x4 f0, f1, b0, b1, r0, r1; unpack8(*(const u32x4*)(GLAF + base), f0, f1); unpack8(*(const u32x4*)(GLAB + base), b0, b1);
                unpack8(*(const u32x4*)(P + (size_t)m * NP + PC_GR + h * 512 + F.lane * 8), r0, r1);
                f0 += b0; f1 += b1;
                float ss = (f0[0] * f0[0] + f0[1] * f0[1]) + (f0[2] * f0[2] + f0[3] * f0[3]) + (f1[0] * f1[0] + f1[1] * f1[1]) + (f1[2] * f1[2] + f1[3] * f1[3]);
                ss = wave_sum(ss); const float rs = 1.f / sqrtf(ss * (1.f / 512.f) + RMS_EPS);
                const f32x4 g0 = *(const f32x4*)(gn + F.lane * 8), g1 = *(const f32x4*)(gn + F.lane * 8 + 4);
#pragma unroll
                for (int j = 0; j < 4; ++j) { f0[j] = f0[j] * rs * g0[j] * (r0[j] * frcp(1.f + fexp2(-r0[j] * LOG2E))); f1[j] = f1[j] * rs * g1[j] * (r1[j] * frcp(1.f + fexp2(-r1[j] * LOG2E))); }
                *(u32x4*)(OGLA + base) = pack8(f0, f1); }
        }
    }
    GRID_BAR();

    { pg8::SchedStd S; S.init(64, 16, F.G, bid, OMLA, 2048, W_bra, 2048);
      pg8::EpiRow8<OpT> E{{MERGED, GATES}};
      pg8::gemm_phase<pg8::EpiRow8<OpT>, pg8::SchedStd, true>(F.lds, 2048, 2048, 2048, S, E); }
    { pg8::SchedStd S; S.init(64, 16, F.G, bid, OGLA, 2048, W_brb, 2048);
      pg8::EpiRow8<OpM> E{{MERGED, GATES}};
      pg8::gemm_phase<pg8::EpiRow8<OpM>, pg8::SchedStd, true>(F.lds, 2048, 2048, 2048, S, E); }
    GRID_BAR();

    { pg8::SchedStd S; S.init(64, 16, F.G, bid, MERGED, 4096, W_out, 4096);
      pg8::EpiRow8<OpY> E{{Y, H}};
      pg8::gemm_phase<pg8::EpiRow8<OpY>, pg8::SchedStd, true>(F.lds, 4096, 4096, 4096, S, E); }
    GRID_BAR();
    for (int m = gw; m < M; m += NGW) ln_row<false>(Y + (size_t)m * DM, INP(18), INP(19), H + (size_t)m * DM, F.lane);
    GRID_BAR();

    { pg8::SchedStd S; S.init(64, 16, F.G, bid, H, 4096, W_xq, 4096);
      pg8::EpiRow8<OpPlain> E{{QX, 4096}};
      pg8::gemm_phase<pg8::EpiRow8<OpPlain>, pg8::SchedStd, true>(F.lds, 4096, 4096, 4096, S, E); }
    { SchedKVmem S{F.G, bid, (const char*)MEMB, (const char*)W_xkv};
      pg8::EpiRow8<OpKVmem> E{{KMEM, VT}};
      pg8::gemm_phase<pg8::EpiRow8<OpKVmem>, SchedKVmem, true>(F.lds, 4096, 4096, 4096, S, E); }
    GRID_BAR();
    { SchedXS S{F.G, bid, (const char*)QX, (const char*)KMEM};
      EpiSoftmax E{PX};
      pg8::gemm_phase<EpiSoftmax, SchedXS, false>(F.lds, 1024, 4096, 4096, S, E); }
    GRID_BAR();
    { SchedXO S{F.G, bid, (const char*)PX, (const char*)VT};
      pg8::EpiRow8<OpPlain> E{{OX, 4096}};
      pg8::gemm_phase<pg8::EpiRow8<OpPlain>, SchedXO, true>(F.lds, 256, 1024, 256, S, E); }
    GRID_BAR();
    { pg8::SchedStd S; S.init(64, 16, F.G, bid, OX, 4096, W_xo, 4096);
      pg8::EpiRow8<OpY> E{{Y, H}};
      pg8::gemm_phase<pg8::EpiRow8<OpY>, pg8::SchedStd, true>(F.lds, 4096, 4096, 4096, S, E); }
    GRID_BAR();
    for (int m = gw; m < M; m += NGW) ln_row<false>(Y + (size_t)m * DM, INP(23), INP(24), H + (size_t)m * DM, F.lane);
    GRID_BAR();

    { pg8::SchedStd S; S.init(64, 64, F.G, bid, H, 4096, W_1, 4096);
      pg8::EpiRow8<OpRelu2> E{{HID}};
      pg8::gemm_phase<pg8::EpiRow8<OpRelu2>, pg8::SchedStd, true>(F.lds, 4096, 4096, 4096, S, E); }
    GRID_BAR();
    { pg8::SchedStd S; S.init(64, 16, F.G, bid, HID, 16384, W_2, 16384);
      pg8::EpiRow8<OpY> E{{Y, H}};
      pg8::gemm_phase<pg8::EpiRow8<OpY>, pg8::SchedStd, true>(F.lds, 16384, 16384, 16384, S, E); }
    GRID_BAR();
    for (int m = gw; m < M; m += NGW) ln_row<true>(Y + (size_t)m * DM, INP(27), INP(28), Y + (size_t)m * DM, F.lane);
}

extern "C" void kernel_launch(void* const* d_in, const int* in_sizes, int n_in, void* d_out, int out_size, void* d_ws, size_t ws_size, hipStream_t stream) {
    static int grid = 0;
    if (grid == 0) {
        if (n_in != 29 || out_size != M * DM || ws_size < WS_END) { fprintf(stderr, "kernel_launch: shape mismatch: n_in %d out %d ws %zu (need %zu); nothing launched\n", n_in, out_size, ws_size, (size_t)WS_END); grid = -1; return; }
        int dev = 0, cus = 0;
        if (hipGetDevice(&dev) != hipSuccess || hipDeviceGetAttribute(&cus, hipDeviceAttributeMultiprocessorCount, dev) != hipSuccess) { grid = -1; return; }
        if (hipFuncSetAttribute((const void*)fwd_kernel, hipFuncAttributeMaxDynamicSharedMemorySize, LDS_BYTES) != hipSuccess) { fprintf(stderr, "kernel_launch: hipFuncSetAttribute failed\n"); grid = -1; return; }
        int per_cu = 0;
        if (hipOccupancyMaxActiveBlocksPerMultiprocessor(&per_cu, (const void*)fwd_kernel, 512, LDS_BYTES) != hipSuccess || per_cu < 1) fprintf(stderr, "kernel_launch: occupancy query says %d\n", per_cu);
        (void)hipGetLastError();
        grid = cus;
        if (grid != 256) fprintf(stderr, "kernel_launch: %d CUs (built for 256)\n", grid);
    }
    if (grid < 0) return;
    if (hipMemsetAsync((char*)d_ws + WS_CTL, 0, CTL_ZERO_BYTES, stream) != hipSuccess) return;
    Args a{};
    for (int i = 0; i < 29; ++i) a.in[i] = (const float*)d_in[i];
    a.out = (float*)d_out; a.ws = (unsigned char*)d_ws;
    hipLaunchKernelGGL(fwd_kernel, dim3(grid), dim3(512), LDS_BYTES, stream, a);
    const hipError_t le = hipPeekAtLastError();
    if (le != hipSuccess) fprintf(stderr, "kernel_launch: launch failed: %s\n", hipGetErrorName(le));
}
```

```cpp
#include <hip/hip_runtime.h>
#include <cstdio>
#include <cstdint>

#define GAS __attribute__((address_space(1)))
#define LAS __attribute__((address_space(3)))
typedef unsigned short bf16;
typedef short bf16x8 __attribute__((ext_vector_type(8)));
typedef short s16x4 __attribute__((ext_vector_type(4)));
typedef short v4i16_t __attribute__((ext_vector_type(4)));
typedef float f32x2 __attribute__((ext_vector_type(2)));
typedef float f32x4 __attribute__((ext_vector_type(4)));
typedef float f32x16 __attribute__((ext_vector_type(16)));
typedef unsigned u32x2 __attribute__((ext_vector_type(2)));
typedef unsigned u32x4 __attribute__((ext_vector_type(4)));
typedef __bf16 bf16x2_t __attribute__((ext_vector_type(2)));
typedef GAS unsigned gu32;

#define DI __device__ __forceinline__
#ifndef DUPMASK
#define DUPMASK 0
#endif
#define REP(k) ((((DUPMASK) >> (k)) & 1) + 1)
#define LDS_WAIT() asm volatile("s_waitcnt lgkmcnt(0)" ::: "memory")
#define VM_WAIT() asm volatile("s_waitcnt vmcnt(0)" ::: "memory")
#define RLX_AGENT __ATOMIC_RELAXED, __HIP_MEMORY_SCOPE_AGENT

DI unsigned pk2(float lo, float hi) { f32x2 v = {lo, hi}; bf16x2_t b = __builtin_convertvector(v, bf16x2_t); return __builtin_bit_cast(unsigned, b); }
DI float bflo(unsigned u) { return __uint_as_float(u << 16); }
DI float bfhi(unsigned u) { return __uint_as_float(u & 0xffff0000u); }
DI float bf1(bf16 h) { return __uint_as_float(((unsigned)h) << 16); }
DI float wave_sum(float v) {
#pragma unroll
    for (int o = 1; o < 64; o <<= 1) v += __shfl_xor(v, o);
    return v;
}
DI float fexp2(float x) { return __builtin_amdgcn_exp2f(x); }
DI float frcp(float x) { return __builtin_amdgcn_rcpf(x); }

constexpr int DM = 4096, M = 16384;
constexpr int NP = 7936;
constexpr int PC_CQ = 0, PC_CKV = 1024, PC_KROPE = 1536, PC_GLR = 1600, PC_GQ = 1792, PC_GK = 2816, PC_GV = 3840, PC_GR = 5888;
constexpr int IN_TOTAL = 15968;
constexpr float LN_EPS = 1e-5f, RMS_EPS = 1e-6f;
constexpr float DN_ALPHA = 1.189207115002721f;
constexpr float LOG2E = 1.4426950408889634f;
constexpr float CQ_MLA = 0.07216878364870322f * LOG2E;
constexpr float CQ_XA = 0.03125f * LOG2E;

constexpr size_t MiB = 1u << 20;
constexpr size_t WS_CTL = 0, CTL_ZERO_BYTES = 1 * MiB;
constexpr size_t WS_ROPE = 1 * MiB;
constexpr size_t WS_RSTD = 2 * MiB;
constexpr size_t WS_KR = 3 * MiB;
constexpr size_t WS_MEMB = 5 * MiB;
constexpr size_t WS_WUQ = 17 * MiB, WS_WUKV = 23 * MiB, WS_WBRA = 27 * MiB, WS_WBRB = 43 * MiB, WS_WOUT = 59 * MiB, WS_WXQ = 91 * MiB,
                 WS_WXKV = 123 * MiB, WS_WXO = 187 * MiB, WS_W1 = 219 * MiB, WS_W2 = 347 * MiB, WS_WIN = 475 * MiB;
constexpr size_t WS_Q = 475 * MiB;
constexpr size_t WS_H = 601 * MiB;
constexpr size_t WS_P = 729 * MiB;
constexpr size_t WS_CUM = 977 * MiB;
constexpr size_t WS_KV = 1105 * MiB;
constexpr size_t WS_OMLA = 1233 * MiB;
constexpr size_t WS_GLAF = 1297 * MiB, WS_GLAB = 1361 * MiB;
constexpr size_t WS_EL = 1425 * MiB;
constexpr size_t WS_END = 1427 * MiB;
constexpr size_t WS_OGLA = WS_KV;
constexpr size_t WS_MERGED = WS_CUM;
constexpr size_t WS_QX = WS_P;
constexpr size_t WS_KMEM = WS_P + 128 * MiB;
constexpr size_t WS_VT = WS_P + 140 * MiB;
constexpr size_t WS_PX = WS_P + 152 * MiB;
constexpr size_t WS_OX = WS_CUM;
constexpr size_t WS_HID = WS_P;
static_assert(WS_HID + (size_t)M * 16384 * 2 <= WS_EL, "hid fits");
static_assert(WS_PX + (size_t)M * 1024 * 2 <= WS_CUM, "px fits");
constexpr int CW_BAR = 4096;
constexpr int CW_QUEUE = 16384;

constexpr int RING_BYTES = 151552;
constexpr int MISC_OFF = RING_BYTES;
constexpr int LDS_BYTES = 159744;

#define XB_TMO      128
#define XB_XCNT(j)  (256  + 64 * (j))
#define XB_XSUB(j)  (1280 + 64 * (j))
#define XB_XGEN(j)  (2304 + 64 * (j))
#define XB_TOP      3328
#define XB_TOPGEN   3392
#define XCD_BAR_WORDS 3456
#define XB_SPIN_CAP (1u << 18)
DI unsigned xb_ld(unsigned* p)              { return __hip_atomic_load(p, __ATOMIC_RELAXED, __HIP_MEMORY_SCOPE_AGENT); }
DI unsigned xb_add(unsigned* p, unsigned v) { return __hip_atomic_fetch_add(p, v, __ATOMIC_RELAXED, __HIP_MEMORY_SCOPE_AGENT); }
DI unsigned xb_xcc_id() { return (unsigned)__builtin_amdgcn_s_getreg((3 << 11) | 20) & 0xFu; }
#define XB_SPIN(cond, bar) do { unsigned _sp = 0; while (cond) { __builtin_amdgcn_s_sleep(1); \
    if ((++_sp & 255u) == 0u) { if (xb_ld(&(bar)[XB_TMO])) break; if (_sp > XB_SPIN_CAP) { atomicAdd(&(bar)[XB_TMO], 1u); break; } } } } while (0)
struct XcdBarrier { unsigned* bar; unsigned x; volatile LAS unsigned* st; };
DI XcdBarrier xcd_barrier_post(unsigned* bar, volatile LAS unsigned* st) {
    XcdBarrier b; b.bar = bar; b.x = xb_xcc_id(); b.st = st;
    if (threadIdx.x == 0) (void)xb_add(&bar[XB_XCNT(b.x)], 1u);
    return b;
}
DI void xcd_barrier_complete(unsigned* bar, unsigned x, unsigned& nloc, unsigned& nx) {
    const unsigned G = gridDim.x * gridDim.y * gridDim.z;
    unsigned sum, cnt, mine, sp = 0u;
    for (;;) {
        sum = 0u; cnt = 0u; mine = 0u;
#pragma unroll
        for (unsigned j = 0; j < 16; ++j) { const unsigned c = xb_ld(&bar[XB_XCNT(j)]); sum += c; cnt += (c > 0u) ? 1u : 0u; mine = (j == x) ? c : mine; }
        if (sum == G) break;
        __builtin_amdgcn_s_sleep(1);
        if ((++sp & 255u) == 0u) { if (xb_ld(&bar[XB_TMO])) break; if (sp > XB_SPIN_CAP) { atomicAdd(&bar[XB_TMO], 1u); break; } }
    }
    nloc = mine > 0u ? mine : 1u; nx = cnt > 0u ? cnt : 1u;
}
DI void xcd_barrier(const XcdBarrier& b) {
    asm volatile("s_waitcnt vmcnt(0)" ::: "memory");
    __syncthreads();
    if (threadIdx.x == 0) {
        unsigned* bar = b.bar;
        __builtin_amdgcn_s_waitcnt(0);
        unsigned nloc = b.st[0], nx = b.st[1];
        if (nloc == 0u) { xcd_barrier_complete(bar, b.x, nloc, nx); b.st[0] = nloc; b.st[1] = nx; }
        const unsigned old = xb_add(&bar[XB_XSUB(b.x)], 1u);
        const unsigned gen = old / nloc;
        if (old + 1u == (gen + 1u) * nloc) {
            __builtin_amdgcn_fence(__ATOMIC_RELEASE, "agent");
            asm volatile("s_waitcnt vmcnt(0)" ::: "memory");
            const unsigned og = xb_add(&bar[XB_TOP], 1u);
            const unsigned tg = og / nx;
            if (og + 1u == (tg + 1u) * nx) xb_add(&bar[XB_TOPGEN], 1u);
            else XB_SPIN(xb_ld(&bar[XB_TOPGEN]) == tg, bar);
            __builtin_amdgcn_fence(__ATOMIC_ACQUIRE, "agent");
            xb_add(&bar[XB_XGEN(b.x)], 1u);
            asm volatile("s_waitcnt vmcnt(0)" ::: "memory");
        } else {
            XB_SPIN(xb_ld(&bar[XB_XGEN(b.x)]) == gen, bar);
            __builtin_amdgcn_fence(__ATOMIC_ACQUIRE, "agent");
            asm volatile("s_waitcnt vmcnt(0)" ::: "memory");
        }
    }
    __syncthreads();
}

namespace pg8 {
constexpr int BM = 256, BK = 64, HALF = 128, HTB = HALF * BK * 2, STAGE_BYTES = 8 * HTB, NXCD = 8, WGM = 8;
DI int lds_byte(int r, int c) { const int st = (r >> 4) * 2 + (c >> 5), rr = r & 15, cc = c & 31, ob = rr * 64 + cc * 2; return st * 1024 + (ob ^ (((ob >> 9) & 1) << 5)); }
DI void stage_rc(int b, int& R, int& C) { const int st = b / 1024, sb = b % 1024, swz = sb ^ (((sb >> 9) & 1) << 5); R = (st >> 1) * 16 + swz / 64; C = (st & 1) * 32 + (swz % 64) / 2; }
DI int perm32(int rho) { const int n = rho >> 4, i = rho & 15; return 8 * (i >> 2) + 4 * n + (i & 3); }

struct Unit { int pm, pn, aux; const char* A; const char* B; };
struct GridOrder {
    int nM, nN, nwg, G, c;
    DI void init(int nM_, int nN_, int G_, int c_) { nM = nM_; nN = nN_; nwg = nM * nN; G = G_; c = c_; }
    DI bool tile(int i, int& pm, int& pn) const {
        const long L = (long)i * G + c; if (L >= nwg) return false;
        int wgid = (int)L; { const int q = nwg / NXCD, r = nwg % NXCD, xcd = wgid % NXCD, off = wgid / NXCD; wgid = (xcd < r ? xcd * (q + 1) : r * (q + 1) + (xcd - r) * q) + off; }
        const int nig = WGM * nN, gid = wgid / nig, fm = gid * WGM, gsz = (nM - fm) < WGM ? (nM - fm) : WGM;
        pm = fm + ((wgid % nig) % gsz); pn = (wgid % nig) / gsz; return true;
    }
};
struct SchedStd {
    GridOrder o; const char* A; const char* B; size_t ast, bst;
    DI void init(int nM, int nN, int G, int c, const void* A_, int lda, const void* B_, int ldb) { o.init(nM, nN, G, c); A = (const char*)A_; B = (const char*)B_; ast = (size_t)256 * lda * 2; bst = (size_t)256 * ldb * 2; }
    DI bool next(int i, Unit& u) const { int pm, pn; if (!o.tile(i, pm, pn)) return false; u.pm = pm; u.pn = pn; u.aux = 0; u.A = A + (size_t)pm * ast; u.B = B + (size_t)pn * bst; return true; }
};

template <class Op> struct EpiRow8 {
    static constexpr bool PERM = true, AFTER_DRAIN = false;
    Op op;
    DI void operator()(const f32x4 (&acc)[2][2][4][2], const Unit& u, int wr, int wc, int fr, int fq) const {
        const int row0 = u.pm * BM + wr * 64 + fr, col0 = u.pn * BM + wc * 32 + 8 * fq;
#pragma unroll
        for (int ai = 0; ai < 2; ++ai)
#pragma unroll
            for (int m = 0; m < 4; ++m) { const int row = row0 + ai * HALF + m * 16;
#pragma unroll
                for (int bj = 0; bj < 2; ++bj) op(u, row, col0 + bj * HALF, acc[ai][bj][m][0], acc[ai][bj][m][1]); }
    }
};

template <class Epi, class Sched, bool ALIGN_EPI>
DI void gemm_phase(LAS unsigned char* lds, const int K, const int lda, const int ldb, const Sched& S, const Epi& E) {
    int tid_ = threadIdx.x; asm volatile("" : "+v"(tid_));
    const int tid = tid_, wid = __builtin_amdgcn_readfirstlane(tid >> 6), lane = tid & 63, wr = wid >> 2, wc = wid & 3, fr = lane & 15, fq = lane >> 4;
    const int nt = K / BK;
    unsigned voffA[2], voffB[2];
#pragma unroll
    for (int i = 0; i < 2; ++i) { int R, C; stage_rc(tid * 16 + i * 8192, R, C); const int Rb = Epi::PERM ? ((R & ~31) + perm32(R & 31)) : R;
        voffA[i] = (unsigned)(R * lda + C) * 2u; voffB[i] = (unsigned)(Rb * ldb + C) * 2u; }
    const size_t kstep = (size_t)(BK * 2);
    const size_t hstepA = (size_t)HALF * lda * 2, hstepB = (size_t)HALF * ldb * 2;
    const unsigned ldsw = (unsigned)wid * 1024u;
    const int aoff = lds_byte(wr * 64 + fr, fq * 8), boff = lds_byte(wc * 32 + fr, fq * 8);
#define PG8_SA(b, h) (((b) * 2 + (h)) * HTB)
#define PG8_SB(b, h) ((4 + (b) * 2 + (h)) * HTB)
#define PG8_STAGE(bufoff, gbase, voff) do { _Pragma("unroll") for (int _i = 0; _i < 2; ++_i) \
        __builtin_amdgcn_global_load_lds((const unsigned*)((const char*)(gbase) + (voff)[_i]), (LAS unsigned*)(lds + (bufoff) + ldsw + _i * 8192), 16, 0, 0); } while (0)
#define PG8_LDA(dst, b, h) do { _Pragma("unroll") for (int m = 0; m < 4; ++m) _Pragma("unroll") for (int k = 0; k < 2; ++k) dst[m][k] = *(const LAS bf16x8*)(lds + PG8_SA(b, h) + aoff + m * 2048 + k * 1024); } while (0)
#define PG8_LDB(dst, b, h) do { _Pragma("unroll") for (int n = 0; n < 2; ++n) _Pragma("unroll") for (int k = 0; k < 2; ++k) dst[n][k] = *(const LAS bf16x8*)(lds + PG8_SB(b, h) + boff + n * 2048 + k * 1024); } while (0)
#define PG8_MMA(ai, bj, At, Bt) do { __builtin_amdgcn_s_setprio(1); _Pragma("unroll") for (int m = 0; m < 4; ++m) _Pragma("unroll") for (int n = 0; n < 2; ++n) _Pragma("unroll") for (int k = 0; k < 2; ++k) \
        acc[ai][bj][m][n] = __builtin_amdgcn_mfma_f32_16x16x32_bf16(Bt[n][k], At[m][k], acc[ai][bj][m][n], 0, 0, 0); __builtin_amdgcn_s_setprio(0); } while (0)
#define PG8_WAIT_V(n) asm volatile("s_waitcnt vmcnt(" #n ")" ::: "memory")
#define PG8_WAIT_L(n) asm volatile("s_waitcnt lgkmcnt(" #n ")" ::: "memory")
#define PG8_BAR __builtin_amdgcn_s_barrier()
#define PG8_SCHED __builtin_amdgcn_sched_barrier(0)
    Unit cur, nxt; int ui = 0;
    if (!S.next(0, cur)) return;
    f32x4 acc[2][2][4][2];
#pragma unroll
    for (int a = 0; a < 2; ++a)
#pragma unroll
        for (int b = 0; b < 2; ++b)
#pragma unroll
            for (int m = 0; m < 4; ++m)
#pragma unroll
                for (int n = 0; n < 2; ++n) acc[a][b][m][n] = (f32x4){0.f, 0.f, 0.f, 0.f};
    bf16x8 At[4][2], B0[2][2], B1[2][2];
    const char* cA = cur.A; const char* cB = cur.B;
    PG8_STAGE(PG8_SB(0, 0), cB, voffB); PG8_STAGE(PG8_SB(0, 1), cB + hstepB, voffB); PG8_STAGE(PG8_SA(0, 0), cA, voffA); PG8_STAGE(PG8_SA(0, 1), cA + hstepA, voffA);
    if (wr == 1) PG8_BAR;
    PG8_WAIT_V(2); PG8_BAR;
    PG8_STAGE(PG8_SB(1, 0), cB + kstep, voffB); PG8_STAGE(PG8_SA(1, 0), cA + kstep, voffA); PG8_STAGE(PG8_SB(1, 1), cB + hstepB + kstep, voffB);
    PG8_WAIT_V(6); PG8_BAR;
    for (;;) {
        const bool has_next = S.next(ui + 1, nxt);
        const char* nA = has_next ? nxt.A : cA; const char* nB = has_next ? nxt.B : cB;
#pragma nounroll
        for (int t = 0; t < nt; t += 2) {
            const bool last = (t == nt - 2);
            const char* a1 = cA + (size_t)(t + 1) * kstep;
            const char* a2 = last ? nA : cA + (size_t)(t + 2) * kstep; const char* b2 = last ? nB : cB + (size_t)(t + 2) * kstep;
            const char* a3 = a2 + kstep; const char* b3 = b2 + kstep;
            PG8_LDB(B0, 0, 0); PG8_LDB(B1, 0, 1); PG8_SCHED; PG8_LDA(At, 0, 0); PG8_STAGE(PG8_SA(1, 1), a1 + hstepA, voffA);
            PG8_WAIT_V(8); PG8_WAIT_L(0); PG8_BAR; PG8_MMA(0, 0, At, B0); PG8_MMA(0, 1, At, B1); PG8_BAR; PG8_SCHED;
            PG8_LDA(At, 0, 1); PG8_STAGE(PG8_SB(0, 0), b2, voffB); PG8_STAGE(PG8_SB(0, 1), b2 + hstepB, voffB); PG8_STAGE(PG8_SA(0, 0), a2, voffA);
            PG8_WAIT_V(8); PG8_WAIT_L(0); PG8_BAR; PG8_MMA(1, 0, At, B0); PG8_MMA(1, 1, At, B1); PG8_BAR; PG8_SCHED;
            PG8_LDB(B0, 1, 0); PG8_LDB(B1, 1, 1); PG8_SCHED; PG8_LDA(At, 1, 0); PG8_STAGE(PG8_SA(0, 1), a2 + hstepA, voffA);
            PG8_WAIT_V(8); PG8_WAIT_L(0); PG8_BAR; PG8_MMA(0, 0, At, B0); PG8_MMA(0, 1, At, B1); PG8_BAR; PG8_SCHED;
            PG8_LDA(At, 1, 1); PG8_STAGE(PG8_SB(1, 0), b3, voffB); PG8_STAGE(PG8_SB(1, 1), b3 + hstepB, voffB); PG8_STAGE(PG8_SA(1, 0), a3, voffA);
            PG8_WAIT_V(8); PG8_WAIT_L(0); PG8_BAR; PG8_MMA(1, 0, At, B0); PG8_MMA(1, 1, At, B1); PG8_BAR; PG8_SCHED;
        }
        if constexpr (ALIGN_EPI) { if (wr == 0) PG8_BAR; }
        if constexpr (!Epi::AFTER_DRAIN) { E(acc, cur, wr, wc, fr, fq); }
        if (!has_next) break;
#pragma unroll
        for (int a = 0; a < 2; ++a)
#pragma unroll
            for (int b = 0; b < 2; ++b)
#pragma unroll
                for (int m = 0; m < 4; ++m)
#pragma unroll
                    for (int n = 0; n < 2; ++n) acc[a][b][m][n] = (f32x4){0.f, 0.f, 0.f, 0.f};
        cur = nxt; cA = nA; cB = nB; ++ui;
        if constexpr (ALIGN_EPI) { if (wr == 1) PG8_BAR; }
    }
    PG8_WAIT_V(0);
    if constexpr (!ALIGN_EPI) { if (wr == 0) PG8_BAR; }
    PG8_BAR;
    if constexpr (Epi::AFTER_DRAIN) { E.fused(acc, cur, wr, wc, fr, fq, lds, wid, lane); }
#undef PG8_SA
#undef PG8_SB
#undef PG8_STAGE
#undef PG8_LDA
#undef PG8_LDB
#undef PG8_MMA
#undef PG8_WAIT_V
#undef PG8_WAIT_L
#undef PG8_BAR
#undef PG8_SCHED
}
}

DI u32x4 pack8(f32x4 a, f32x4 b) { u32x4 w; w.x = pk2(a[0], a[1]); w.y = pk2(a[2], a[3]); w.z = pk2(b[0], b[1]); w.w = pk2(b[2], b[3]); return w; }
DI void unpack8(u32x4 w, f32x4& a, f32x4& b) { a = (f32x4){bflo(w.x), bfhi(w.x), bflo(w.y), bfhi(w.y)}; b = (f32x4){bflo(w.z), bfhi(w.z), bflo(w.w), bfhi(w.w)}; }
DI int seq_pos(int row) { return row < 8192 ? (row & 2047) : (row & 4095); }
DI int seq_of_pm(int pm) { return pm < 32 ? (pm >> 3) : 4 + ((pm - 32) >> 4); }

struct OpPlain { bf16* O; int ldc;
    DI void operator()(const pg8::Unit&, int row, int col, f32x4 v0, f32x4 v1) const { *(u32x4*)(O + (size_t)row * ldc + col) = pack8(v0, v1); } };
struct OpG1 { bf16* P; bf16* G; const float* bm;
    DI void operator()(const pg8::Unit& u, int row, int col, f32x4 v0, f32x4 v1) const {
        if (u.pn < 31) { *(u32x4*)(P + (size_t)row * NP + col) = pack8(v0, v1); }
        else { const int c = col - NP; const f32x4 b0 = *(const f32x4*)(bm + c), b1 = *(const f32x4*)(bm + c + 4);
#pragma unroll
            for (int j = 0; j < 4; ++j) { v0[j] = frcp(1.f + fexp2(-(v0[j] + b0[j]) * LOG2E)); v1[j] = frcp(1.f + fexp2(-(v1[j] + b1[j]) * LOG2E)); }
            *(u32x4*)(G + (size_t)row * 8192 + c) = pack8(v0, v1); }
    } };
struct OpQ { bf16* Q; const float* rstd; const float* cosT; const float* sinT;
    DI void operator()(const pg8::Unit&, int row, int col, f32x4 v0, f32x4 v1) const {
        const float r = rstd[row]; v0 *= r; v1 *= r;
        const int w = col % 192;
        if (w >= 128) { const int i0 = (w - 128) >> 1, pos = seq_pos(row);
            const f32x4 c = *(const f32x4*)(cosT + pos * 32 + i0), s = *(const f32x4*)(sinT + pos * 32 + i0);
            const f32x4 a0 = v0, a1 = v1;
            v0[0] = a0[0] * c[0] - a0[1] * s[0]; v0[1] = a0[1] * c[0] + a0[0] * s[0];
            v0[2] = a0[2] * c[1] - a0[3] * s[1]; v0[3] = a0[3] * c[1] + a0[2] * s[1];
            v1[0] = a1[0] * c[2] - a1[1] * s[2]; v1[1] = a1[1] * c[2] + a1[0] * s[2];
            v1[2] = a1[2] * c[3] - a1[3] * s[3]; v1[3] = a1[3] * c[3] + a1[2] * s[3]; }
        *(u32x4*)(Q + (size_t)row * 3072 + col) = pack8(v0, v1);
    } };
struct OpKV { bf16* KV; const float* rstd;
    DI void operator()(const pg8::Unit&, int row, int col, f32x4 v0, f32x4 v1) const { const float r = rstd[row]; *(u32x4*)(KV + (size_t)row * 4096 + col) = pack8(v0 * r, v1 * r); } };
struct OpT { bf16* T; const bf16* G;
    DI void operator()(const pg8::Unit&, int row, int col, f32x4 v0, f32x4 v1) const { f32x4 g0, g1; unpack8(*(const u32x4*)(G + (size_t)row * 8192 + col), g0, g1);
        *(u32x4*)(T + (size_t)row * 4096 + col) = pack8(g0 * v0, g1 * v1); } };
struct OpM { bf16* T; const bf16* G;
    DI void operator()(const pg8::Unit&, int row, int col, f32x4 v0, f32x4 v1) const { f32x4 g0, g1, t0, t1; unpack8(*(const u32x4*)(G + (size_t)row * 8192 + 4096 + col), g0, g1);
        unpack8(*(const u32x4*)(T + (size_t)row * 4096 + col), t0, t1); *(u32x4*)(T + (size_t)row * 4096 + col) = pack8(t0 + g0 * v0, t1 + g1 * v1); } };
struct OpY { float* Y; const bf16* H;
    DI void operator()(const pg8::Unit&, int row, int col, f32x4 v0, f32x4 v1) const { f32x4 h0, h1; unpack8(*(const u32x4*)(H + (size_t)row * 4096 + col), h0, h1);
        float* y = Y + (size_t)row * 4096 + col; *(f32x4*)y = h0 * DN_ALPHA + v0; *(f32x4*)(y + 4) = h1 * DN_ALPHA + v1; } };
struct OpRelu2 { bf16* O;
    DI void operator()(const pg8::Unit&, int row, int col, f32x4 v0, f32x4 v1) const {
#pragma unroll
        for (int j = 0; j < 4; ++j) { const float a = fmaxf(v0[j], 0.f), b = fmaxf(v1[j], 0.f); v0[j] = a * a; v1[j] = b * b; }
        *(u32x4*)(O + (size_t)row * 16384 + col) = pack8(v0, v1); } };
struct OpKVmem { bf16* KMEM; bf16* VT;
    DI void operator()(const pg8::Unit& u, int row, int col, f32x4 v0, f32x4 v1) const {
        if (u.aux == 0) *(u32x4*)(KMEM + (size_t)row * 4096 + col) = pack8(v0, v1);
        else *(u32x4*)(VT + (size_t)(u.aux - 1) * (4096 * 256) + (size_t)row * 256 + col) = pack8(v0, v1); } };

struct EpiSoftmax {
    static constexpr bool PERM = true, AFTER_DRAIN = true;
    bf16* PX;
    DI void fused(f32x4 (&acc)[2][2][4][2], const pg8::Unit& u, int wr, int wc, int fr, int fq, LAS unsigned char* lds, int wid, int lane) const {
        LAS float* T1 = (LAS float*)lds; LAS float* T2 = (LAS float*)(lds + 4096);
        float mx[2][4];
#pragma unroll
        for (int ai = 0; ai < 2; ++ai)
#pragma unroll
            for (int m = 0; m < 4; ++m) { float v = -3.0e38f;
#pragma unroll
                for (int bj = 0; bj < 2; ++bj)
#pragma unroll
                    for (int n = 0; n < 2; ++n)
#pragma unroll
                        for (int j = 0; j < 4; ++j) v = fmaxf(v, acc[ai][bj][m][n][j]);
                v = fmaxf(v, __shfl_xor(v, 16)); v = fmaxf(v, __shfl_xor(v, 32));
                if (fq == 0) T1[(ai * 128 + wr * 64 + m * 16 + fr) * 4 + wc] = v; }
        LDS_WAIT(); __builtin_amdgcn_s_barrier(); asm volatile("" ::: "memory");
#pragma unroll
        for (int ai = 0; ai < 2; ++ai)
#pragma unroll
            for (int m = 0; m < 4; ++m) { const int r = ai * 128 + wr * 64 + m * 16 + fr; const f32x4 t = *(const LAS f32x4*)(T1 + r * 4);
                const float mr = fmaxf(fmaxf(t[0], t[1]), fmaxf(t[2], t[3])); float s = 0.f;
#pragma unroll
                for (int bj = 0; bj < 2; ++bj)
#pragma unroll
                    for (int n = 0; n < 2; ++n)
#pragma unroll
                        for (int j = 0; j < 4; ++j) { const float p = fexp2(acc[ai][bj][m][n][j] - mr); acc[ai][bj][m][n][j] = p; s += p; }
                s += __shfl_xor(s, 16); s += __shfl_xor(s, 32);
                if (fq == 0) T2[r * 4 + wc] = s; }
        LDS_WAIT(); __builtin_amdgcn_s_barrier(); asm volatile("" ::: "memory");
        const int row0 = u.pm * 256 + wr * 64 + fr, col0 = u.pn * 256 + wc * 32 + 8 * fq;
#pragma unroll
        for (int ai = 0; ai < 2; ++ai)
#pragma unroll
            for (int m = 0; m < 4; ++m) { const int r = ai * 128 + wr * 64 + m * 16 + fr; const f32x4 t = *(const LAS f32x4*)(T2 + r * 4);
                const float inv = 1.0f / ((t[0] + t[1]) + (t[2] + t[3]));
#pragma unroll
                for (int bj = 0; bj < 2; ++bj) *(u32x4*)(PX + (size_t)(row0 + ai * 128 + m * 16) * 1024 + col0 + bj * 128) = pack8(acc[ai][bj][m][0] * inv, acc[ai][bj][m][1] * inv); }
        LDS_WAIT(); __builtin_amdgcn_s_barrier();
    }
};
struct SchedKVmem {
    int G, c; const char* MEMB; const char* W;
    DI bool next(int i, pg8::Unit& u) const { const int L = i * G + c; if (L >= 192) return false;
        if (L < 96) { const int b = L >> 4, pn = L & 15; u.pm = b; u.pn = pn; u.aux = 0; u.A = MEMB + (size_t)b * 256 * 4096 * 2; u.B = W + (size_t)pn * 256 * 4096 * 2; }
        else { const int l = L - 96, b = l >> 4, pmw = l & 15; u.pm = pmw; u.pn = 0; u.aux = 1 + b; u.A = W + (size_t)(4096 + pmw * 256) * 4096 * 2; u.B = MEMB + (size_t)b * 256 * 4096 * 2; }
        return true; } };
struct SchedXS {
    int G, c; const char* QX; const char* KMEM;
    DI bool next(int i, pg8::Unit& u) const { const int L = i * G + c; if (L >= 256) return false; const int pm = L >> 2, h = L & 3;
        u.pm = pm; u.pn = h; u.aux = 0; u.A = QX + (size_t)pm * 256 * 4096 * 2 + h * 1024 * 2; u.B = KMEM + (size_t)seq_of_pm(pm) * 256 * 4096 * 2 + h * 1024 * 2; return true; } };
struct SchedXO {
    int G, c; const char* PX; const char* VT;
    DI bool next(int i, pg8::Unit& u) const { const int L = i * G + c; if (L >= 1024) return false; const int pm = L >> 4, pn = L & 15;
        u.pm = pm; u.pn = pn; u.aux = 0; u.A = PX + (size_t)pm * 256 * 1024 * 2 + (pn >> 2) * 256 * 2; u.B = VT + (size_t)seq_of_pm(pm) * (4096 * 256 * 2) + (size_t)pn * 256 * 256 * 2; return true; } };

struct Frame {
    LAS unsigned char* lds; volatile LAS unsigned* MISC; gu32* ctl;
    int tid, lane, wave, G, vcu;
    unsigned char* ws;
};
constexpr int TAB_OFF = MISC_OFF + 512;
DI const float* in_ptr(const Frame& F, int i) {
    const LAS unsigned* t = (const LAS unsigned*)(F.lds + TAB_OFF) + 2 * i;
    const unsigned lo = __builtin_amdgcn_readfirstlane(t[0]), hi = __builtin_amdgcn_readfirstlane(t[1]);
    return (const float*)(const GAS float*)(((unsigned long long)hi << 32) | lo);
}

struct MapId { static DI int map(int n) { return n; } };
struct MapWin { static DI int map(int n) { return n < 1600 ? n : (n < 7744 ? n + 192 : (n < 7776 ? n - 7744 + 1600 : n + 160)); } };
struct MapUq { static DI int map(int n) { const int h = n / 192, w = n - h * 192; if (w < 128) return n; const int i = w - 128; return h * 192 + 128 + (i < 32 ? 2 * i : 2 * (i - 32) + 1); } };
template <class Map>
DI void tr_item(const float* W, int K, int N, bf16* WT, LAS float* scr, int item, int lane, const float* kgain, float scale) {
    const int nblk = N / 32, kb = item / nblk, nb = item - kb * nblk, k0 = 64 * kb, n0 = 32 * nb;
    float w[32];
#pragma unroll
    for (int i = 0; i < 32; ++i) { const int kk = 2 * i + (lane >> 5); w[i] = W[(size_t)(k0 + kk) * N + n0 + (lane & 31)]; }
#pragma unroll
    for (int i = 0; i < 32; ++i) { const int kk = 2 * i + (lane >> 5); const float g = kgain ? kgain[k0 + kk] * scale : scale; scr[kk * 33 + (lane & 31)] = w[i] * g; }
    LDS_WAIT(); asm volatile("" ::: "memory");
    const int c = lane & 7;
#pragma unroll
    for (int j = 0; j < 4; ++j) { const int n = (lane >> 3) + 8 * j; const LAS float* s = scr + (8 * c) * 33 + n;
        u32x4 o; o.x = pk2(s[0 * 33], s[1 * 33]); o.y = pk2(s[2 * 33], s[3 * 33]); o.z = pk2(s[4 * 33], s[5 * 33]); o.w = pk2(s[6 * 33], s[7 * 33]);
        *(GAS u32x4*)(WT + (size_t)Map::map(n0 + n) * K + k0 + 8 * c) = o; }
    LDS_WAIT(); asm volatile("" ::: "memory");
}
template <bool OUT_F32>
DI void ln_row(const float* src, const float* g, const float* b, void* dst, int lane) {
    const GAS f32x4* xr = (const GAS f32x4*)src + lane;
    f32x4 v[16]; float s = 0.f;
#pragma unroll
    for (int j = 0; j < 16; ++j) { v[j] = xr[64 * j]; s += (v[j].x + v[j].y) + (v[j].z + v[j].w); }
    const float mean = wave_sum(s) * (1.f / 4096.f); float s2 = 0.f;
#pragma unroll
    for (int j = 0; j < 16; ++j) { v[j] = v[j] - mean; s2 += (v[j].x * v[j].x + v[j].y * v[j].y) + (v[j].z * v[j].z + v[j].w * v[j].w); }
    const float rstd = 1.f / sqrtf(wave_sum(s2) * (1.f / 4096.f) + LN_EPS);
#pragma unroll
    for (int j = 0; j < 16; ++j) { const f32x4 gg = ((const GAS f32x4*)g)[lane + 64 * j], bb = ((const GAS f32x4*)b)[lane + 64 * j]; const f32x4 y = v[j] * rstd * gg + bb;
        if (OUT_F32) ((GAS f32x4*)dst)[lane + 64 * j] = y;
        else { u32x2 o; o.x = pk2(y.x, y.y); o.y = pk2(y.z, y.w); ((GAS u32x2*)dst)[lane + 64 * j] = o; } }
}

namespace att {
constexpr int NW = 8, QBLK = 32, KVBLK = 64;
constexpr int LDQ = 3072, LDKV = 4096, LDKR = 64, LDO = 2048;
constexpr int SHM_V = KVBLK * 128 * 2, SHM_K = KVBLK * 128 * 2, SHM_KR = KVBLK * 64 * 2;
constexpr int OFF_V = 0, OFF_K = 2 * SHM_V, OFF_KR = OFF_K + 2 * SHM_K, OFF_WS = OFF_KR + 2 * SHM_KR, OFF_QX = OFF_WS + NW * 64 * 4, LDS_BYTES = OFF_QX + NW * 8192;
static_assert(LDS_BYTES <= RING_BYTES, "attention LDS");
constexpr float THRL = 11.5f;
constexpr int SDEPTH = 1;
#define KSWZ(row, colB) ((row) * 256 + ((colB) ^ (((row) & 7) << 4)))
#define SBAR() __builtin_amdgcn_sched_barrier(0)
DI int crow(int r, int hi) { return (r & 3) + 8 * (r >> 2) + 4 * hi; }
DI void partialSM(f32x16& p0, f32x16& p1, float& m_reg, float& mn, float& alpha) {
    float pmax = p0[0];
#pragma unroll
    for (int r = 1; r < 16; ++r) pmax = fmaxf(pmax, p0[r]);
#pragma unroll
    for (int r = 0; r < 16; ++r) pmax = fmaxf(pmax, p1[r]);
    { auto rr = __builtin_amdgcn_permlane32_swap(__float_as_uint(pmax), __float_as_uint(pmax), false, false); pmax = fmaxf(__uint_as_float(rr[0]), __uint_as_float(rr[1])); }
    if (__builtin_expect(__all(pmax - m_reg <= THRL), 1)) { mn = m_reg; alpha = 1.f; }
    else { mn = fmaxf(m_reg, pmax); alpha = fexp2(m_reg - mn); m_reg = mn; }
#pragma unroll
    for (int r = 0; r < 16; ++r) p0[r] = p0[r] - mn;
#pragma unroll
    for (int r = 0; r < 16; ++r) p1[r] = p1[r] - mn;
#pragma unroll
    for (int r = 0; r < 16; ++r) p0[r] = fexp2(p0[r]);
}
DI void finishSM(f32x16& p0, f32x16& p1, float alpha, float& l_reg, bf16x8& pa0, bf16x8& pa1, bf16x8& pa2, bf16x8& pa3) {
#pragma unroll
    for (int r = 0; r < 16; ++r) p1[r] = fexp2(p1[r]);
    float ps = 0;
#pragma unroll
    for (int r = 0; r < 16; ++r) ps += p0[r];
#pragma unroll
    for (int r = 0; r < 16; ++r) ps += p1[r];
    { auto rr = __builtin_amdgcn_permlane32_swap(__float_as_uint(ps), __float_as_uint(ps), false, false); ps = __uint_as_float(rr[0]) + __uint_as_float(rr[1]); }
    l_reg = l_reg * alpha + ps;
#define PK4(P, BASE, OUT) do { unsigned a0 = pk2(P[BASE + 0], P[BASE + 1]), a1 = pk2(P[BASE + 2], P[BASE + 3]);   \
    unsigned b0 = pk2(P[BASE + 4], P[BASE + 5]), b1 = pk2(P[BASE + 6], P[BASE + 7]);                              \
    auto r0 = __builtin_amdgcn_permlane32_swap(a0, b0, false, false); auto r1 = __builtin_amdgcn_permlane32_swap(a1, b1, false, false); \
    u32x4 w = {r0[0], r1[0], r0[1], r1[1]}; OUT = __builtin_bit_cast(bf16x8, w); } while (0)
    PK4(p0, 0, pa0); PK4(p0, 8, pa1); PK4(p1, 0, pa2); PK4(p1, 8, pa3);
#undef PK4
}
DI void qkt(f32x16& p0, f32x16& p1, const char* Ks, const char* KRs, const bf16x8* qr, const char* qxl, int r32, int hi) {
#pragma unroll
    for (int r = 0; r < 16; ++r) { p0[r] = 0.f; p1[r] = 0.f; }
    const int sw = (r32 >> 1) & 7;
#pragma unroll
    for (int d0 = 0; d0 < 8; ++d0) { const int cb = (d0 * 16 + hi * 8) * 2;
        const bf16x8 b0 = *reinterpret_cast<const bf16x8*>(Ks + KSWZ(r32, cb));
        const bf16x8 b1 = *reinterpret_cast<const bf16x8*>(Ks + KSWZ(32 + r32, cb));
        const bf16x8 qf = d0 < 4 ? qr[d0 & 3] : *reinterpret_cast<const bf16x8*>(qxl + 4096 + r32 * 128 + (((2 * (d0 & 3) + hi) ^ sw) << 4));
        p0 = __builtin_amdgcn_mfma_f32_32x32x16_bf16(b0, qf, p0, 0, 0, 0);
        p1 = __builtin_amdgcn_mfma_f32_32x32x16_bf16(b1, qf, p1, 0, 0, 0); }
#pragma unroll
    for (int d0 = 0; d0 < 4; ++d0) { const int ch = (2 * d0 + hi) ^ sw;
        const bf16x8 b0 = *reinterpret_cast<const bf16x8*>(KRs + r32 * 128 + ch * 16);
        const bf16x8 b1 = *reinterpret_cast<const bf16x8*>(KRs + (32 + r32) * 128 + ch * 16);
        const bf16x8 qx = *reinterpret_cast<const bf16x8*>(qxl + r32 * 128 + ch * 16);
        p0 = __builtin_amdgcn_mfma_f32_32x32x16_bf16(b0, qx, p0, 0, 0, 0);
        p1 = __builtin_amdgcn_mfma_f32_32x32x16_bf16(b1, qx, p1, 0, 0, 0); }
}
DI int v_st(int k, int c) { const int kk = (k & ~0xC) | ((k & 4) << 1) | ((k & 8) >> 1); return ((kk >> 3) * 4 + (c >> 5)) * 512 + ((kk & 7) * 32 + (c & 31)) * 2; }
DI int v_rd_base(int lane) { return ((lane & 3) << 3) | (((lane >> 2) & 3) << 6) | (((lane >> 4) & 1) << 5) | (((lane >> 5) & 1) << 8); }
constexpr int v_rd_off(int d0, int ks, int half) { return d0 * 512 + ks * 4096 + half * 2048; }
template <int OFF> DI s16x4 tr_read(int vb) { s16x4 r; asm volatile("ds_read_b64_tr_b16 %0, %1 offset:%2" : "=&v"(r) : "v"(vb), "i"(OFF) : "memory"); return r; }
template <int D0> DI void pv_one(f32x16& od, int vb, bf16x8 pa0, bf16x8 pa1, bf16x8 pa2, bf16x8 pa3) {
    const s16x4 l0 = tr_read<v_rd_off(D0, 0, 0)>(vb), h0 = tr_read<v_rd_off(D0, 0, 1)>(vb), l1 = tr_read<v_rd_off(D0, 1, 0)>(vb), h1 = tr_read<v_rd_off(D0, 1, 1)>(vb);
    const s16x4 l2 = tr_read<v_rd_off(D0, 2, 0)>(vb), h2 = tr_read<v_rd_off(D0, 2, 1)>(vb), l3 = tr_read<v_rd_off(D0, 3, 0)>(vb), h3 = tr_read<v_rd_off(D0, 3, 1)>(vb);
    asm volatile("s_waitcnt lgkmcnt(0)" ::: "memory"); SBAR();
#define PK(L, H) (bf16x8){L[0], L[1], L[2], L[3], H[0], H[1], H[2], H[3]}
    od = __builtin_amdgcn_mfma_f32_32x32x16_bf16(pa0, PK(l0, h0), od, 0, 0, 0);
    od = __builtin_amdgcn_mfma_f32_32x32x16_bf16(pa1, PK(l1, h1), od, 0, 0, 0);
    od = __builtin_amdgcn_mfma_f32_32x32x16_bf16(pa2, PK(l2, h2), od, 0, 0, 0);
    od = __builtin_amdgcn_mfma_f32_32x32x16_bf16(pa3, PK(l3, h3), od, 0, 0, 0);
#undef PK
}
DI void pv_d0(f32x16* o, int vb, bf16x8 pa0, bf16x8 pa1, bf16x8 pa2, bf16x8 pa3) {
    pv_one<0>(o[0], vb, pa0, pa1, pa2, pa3); pv_one<1>(o[1], vb, pa0, pa1, pa2, pa3); pv_one<2>(o[2], vb, pa0, pa1, pa2, pa3); pv_one<3>(o[3], vb, pa0, pa1, pa2, pa3);
}
DI void attn_unit(const bf16* __restrict__ Qb, const bf16* __restrict__ Kh, const bf16* __restrict__ Vh, const bf16* __restrict__ KRh, bf16* __restrict__ Ob, int seq, char* lds) {
    int tid_ = threadIdx.x; asm volatile("" : "+v"(tid_));
    const int tid = tid_, wid = tid >> 6, lane = tid & 63, r32 = lane & 31, hi = lane >> 5;
    char* V_lds = lds + OFF_V; char* K_lds = lds + OFF_K; char* KR_lds = lds + OFF_KR;
    float* wsf = (float*)(lds + OFF_WS) + wid * 64; float* li_l = wsf; float* al_l = wsf + 32;
    float m_reg = -1e30f, l_reg = 0; f32x16 o[4]; bf16x8 qr[4];
    char* qxl = lds + OFF_QX + wid * 8192;
#pragma unroll
    for (int d = 0; d < 4; ++d)
#pragma unroll
        for (int r = 0; r < 16; ++r) o[d][r] = 0.f;
    const bf16* Qw = Qb + (long)(wid * QBLK + r32) * LDQ + hi * 8;
#pragma unroll
    for (int d0 = 0; d0 < 4; ++d0) qr[d0] = *reinterpret_cast<const bf16x8*>(Qw + d0 * 16);
#pragma unroll
    for (int d0 = 0; d0 < 4; ++d0) *reinterpret_cast<bf16x8*>(qxl + 4096 + r32 * 128 + (((2 * d0 + hi) ^ ((r32 >> 1) & 7)) << 4)) = *reinterpret_cast<const bf16x8*>(Qw + 64 + d0 * 16);
#pragma unroll
    for (int d0 = 0; d0 < 4; ++d0) *reinterpret_cast<bf16x8*>(qxl + r32 * 128 + (((2 * d0 + hi) ^ ((r32 >> 1) & 7)) << 4)) = *reinterpret_cast<const bf16x8*>(Qw + 128 + d0 * 16);
    const int sr = tid >> 4, sc = (tid & 15) * 8, vst0 = v_st(sr, sc), vst1 = v_st(32 + sr, sc);
    const int krr = tid >> 3, krc = tid & 7, krst = krr * 128 + ((krc ^ ((krr >> 1) & 7)) << 4);
    const int vb0 = (int)(uintptr_t)V_lds + v_rd_base(lane);
    struct { bf16x8 vs0, vs1, ks0, ks1, kr; } sr_[SDEPTH];
#define SLOAD(i, k0) do { sr_[i].vs0 = *reinterpret_cast<const bf16x8*>(&Vh[(long)((k0) + sr) * LDKV + sc]); sr_[i].vs1 = *reinterpret_cast<const bf16x8*>(&Vh[(long)((k0) + 32 + sr) * LDKV + sc]); \
    sr_[i].ks0 = *reinterpret_cast<const bf16x8*>(&Kh[(long)((k0) + sr) * LDKV + sc]); sr_[i].ks1 = *reinterpret_cast<const bf16x8*>(&Kh[(long)((k0) + 32 + sr) * LDKV + sc]); \
    sr_[i].kr = *reinterpret_cast<const bf16x8*>(&KRh[(long)((k0) + krr) * LDKR + krc * 8]); } while (0)
#define SWRITE(b, i) do { *(bf16x8*)(V_lds + (b) * SHM_V + vst0) = sr_[i].vs0; *(bf16x8*)(V_lds + (b) * SHM_V + vst1) = sr_[i].vs1; const int kc = sc * 2; \
    *(bf16x8*)(K_lds + (b) * SHM_K + KSWZ(sr, kc)) = sr_[i].ks0; *(bf16x8*)(K_lds + (b) * SHM_K + KSWZ(32 + sr, kc)) = sr_[i].ks1; \
    *(bf16x8*)(KR_lds + (b) * SHM_KR + krst) = sr_[i].kr; } while (0)
#define SWAIT() do { if constexpr (SDEPTH == 2) asm volatile("s_waitcnt vmcnt(5)" ::: "memory"); else asm volatile("s_waitcnt vmcnt(0)" ::: "memory"); } while (0)
#define RESC(a) do { if (__any((a) < 1.f)) { if (hi == 0) al_l[r32] = (a); asm volatile("s_waitcnt lgkmcnt(0)" ::: "memory"); \
    _Pragma("unroll") for (int d = 0; d < 4; ++d) _Pragma("unroll") for (int r = 0; r < 16; ++r) o[d][r] *= al_l[crow(r, hi)]; } } while (0)
    f32x16 pA0, pA1, pB0, pB1; float mnA, mnB, alA, alB; bf16x8 pa0, pa1, pa2, pa3; const int NT = seq / KVBLK;
    constexpr int SE = 0, SO = SDEPTH - 1;
    SLOAD(SE, 0); asm volatile("s_waitcnt vmcnt(0)" ::: "memory"); SWRITE(0, SE); __syncthreads();
    qkt(pA0, pA1, K_lds, KR_lds, qr, qxl, r32, hi); partialSM(pA0, pA1, m_reg, mnA, alA);
    SLOAD(SO, KVBLK); if constexpr (SDEPTH == 2) { if (2 < NT) SLOAD(SE, 2 * KVBLK); }
    SWAIT(); SWRITE(1, SO); __syncthreads();
    for (int j = 1; j + 1 < NT; j += 2) {
        SBAR(); qkt(pB0, pB1, K_lds + SHM_K, KR_lds + SHM_KR, qr, qxl, r32, hi);
        finishSM(pA0, pA1, alA, l_reg, pa0, pa1, pa2, pa3); SBAR();
        SLOAD(SO, (j + SDEPTH) * KVBLK); SBAR();
        pv_d0(o, vb0, pa0, pa1, pa2, pa3); partialSM(pB0, pB1, m_reg, mnB, alB);
        __syncthreads(); SWAIT(); SWRITE(0, SE);
        RESC(alB); __syncthreads();
        SBAR(); qkt(pA0, pA1, K_lds, KR_lds, qr, qxl, r32, hi);
        finishSM(pB0, pB1, alB, l_reg, pa0, pa1, pa2, pa3); SBAR();
        if (SDEPTH == 1 || j + 3 < NT) SLOAD(SE, (j + 1 + SDEPTH) * KVBLK); SBAR();
        pv_d0(o, vb0 + SHM_V, pa0, pa1, pa2, pa3); partialSM(pA0, pA1, m_reg, mnA, alA);
        __syncthreads(); SWAIT(); SWRITE(1, SO);
        RESC(alA); __syncthreads();
    }
    SBAR(); qkt(pB0, pB1, K_lds + SHM_K, KR_lds + SHM_KR, qr, qxl, r32, hi);
    finishSM(pA0, pA1, alA, l_reg, pa0, pa1, pa2, pa3); SBAR();
    pv_d0(o, vb0, pa0, pa1, pa2, pa3); partialSM(pB0, pB1, m_reg, mnB, alB);
    __syncthreads(); RESC(alB);
    finishSM(pB0, pB1, alB, l_reg, pa0, pa1, pa2, pa3); SBAR();
    pv_d0(o, vb0 + SHM_V, pa0, pa1, pa2, pa3);
    if (hi == 0) li_l[r32] = l_reg; asm volatile("s_waitcnt lgkmcnt(0)" ::: "memory");
    float rli[16];
#pragma unroll
    for (int r = 0; r < 16; ++r) rli[r] = frcp(li_l[crow(r, hi)]);
    bf16* Ow = Ob + (long)(wid * QBLK) * LDO;
#pragma unroll
    for (int r = 0; r < 16; ++r) { const int orow = crow(r, hi);
#pragma unroll
        for (int d0 = 0; d0 < 4; ++d0) Ow[(long)orow * LDO + d0 * 32 + r32] = (bf16)(pk2(o[d0][r] * rli[r], 0.f) & 0xffffu); }
    __syncthreads();
#undef SLOAD
#undef SWRITE
#undef SWAIT
#undef RESC
}
}

namespace gla {
constexpr int RSQ = 528, RS = 544, RSV = 288, RSA = 144;
constexpr int OFF_QD = 0, OFF_KI = 64 * RSQ, OFF_V = 64 * RSQ + 64 * RS, OFF_AI = OFF_V + 64 * RSV, OFF_EL = OFF_AI + 64 * RSA, LDS_BYTES = OFF_EL + 1024;
static_assert(LDS_BYTES <= RING_BYTES, "gla LDS");
DI s16x4 trr(LAS const unsigned char* p) { return __builtin_bit_cast(s16x4, __builtin_amdgcn_ds_read_tr16_b64_v4i16((LAS v4i16_t*)p)); }
DI bf16x8 cat8(s16x4 a, s16x4 b) { return (bf16x8){a[0], a[1], a[2], a[3], b[0], b[1], b[2], b[3]}; }
struct Raw { u32x4 q[4], k[4]; u32x2 v[4]; f32x4 el; };
DI void load_raw(Raw& R, const bf16* P, const bf16* QDd, const bf16* KId, const float* ELd, int r0, int h, int slice, int tg, int col8, int dv4, int l64) {
#pragma unroll
    for (int i = 0; i < 4; ++i) { const size_t row = (size_t)(r0 + 4 * tg + i);
        R.q[i] = *(const u32x4*)(QDd + row * 1024 + h * 256 + 8 * col8);
        R.k[i] = *(const u32x4*)(KId + row * 1024 + h * 256 + 8 * col8);
        R.v[i] = *(const u32x2*)(P + row * NP + PC_GV + h * 512 + slice * 128 + 4 * dv4); }
    R.el = *(const f32x4*)(ELd + (size_t)(r0 >> 6) * 1024 + h * 256 + 4 * l64);
}
DI void gla_item(const bf16* __restrict__ P, const bf16* __restrict__ QD, const bf16* __restrict__ KI, const float* __restrict__ EL, bf16* __restrict__ OUTF, bf16* __restrict__ OUTB, int item, LAS unsigned char* lds) {
    int tid_ = threadIdx.x; asm volatile("" : "+v"(tid_));
    const int tid = tid_, w = __builtin_amdgcn_readfirstlane(tid >> 6), lane = tid & 63, l15 = lane & 15, g = lane >> 4, q4 = (lane >> 2) & 3, p4 = lane & 3;
    const int xcd = item & 7, jj = item >> 3, slice = jj & 3, grp = (jj >> 2) * 8 + xcd, seq = grp >> 3, h = (grp >> 1) & 3, dir = grp & 1;
    const int row0 = seq < 4 ? seq * 2048 : 8192 + (seq - 4) * 4096, nch = seq < 4 ? 32 : 64;
    const bf16* QDd = QD + (size_t)dir * M * 1024; const bf16* KId = KI + (size_t)dir * M * 1024; const float* ELd = EL + (size_t)dir * (M / 64) * 1024;
    bf16* OUT = dir ? OUTB : OUTF;
    const int col8 = tid & 31, tg = tid >> 5, dv4 = tid & 31;
    f32x4 S[16];
#pragma unroll
    for (int i = 0; i < 16; ++i) S[i] = (f32x4){0.f, 0.f, 0.f, 0.f};
    Raw R;
    load_raw(R, P, QDd, KId, ELd, row0 + 64 * (dir ? nch - 1 : 0), h, slice, tg, col8, dv4, lane);
    for (int n = 0; n < nch; ++n) {
        const int ch = dir ? nch - 1 - n : n, r0 = row0 + 64 * ch;
#pragma unroll
        for (int i = 0; i < 4; ++i) { const int tok = 4 * tg + i;
            *(LAS u32x4*)(lds + OFF_QD + tok * RSQ + col8 * 16) = R.q[i];
            *(LAS u32x4*)(lds + OFF_KI + tok * RS + col8 * 16) = R.k[i];
            *(LAS u32x2*)(lds + OFF_V + tok * RSV + dv4 * 8) = R.v[i]; }
        if (w == 0) *(LAS f32x4*)(lds + OFF_EL + lane * 16) = R.el;
        LDS_WAIT(); __builtin_amdgcn_s_barrier(); asm volatile("" ::: "memory");
        if (n + 1 < nch) { const int ch2 = dir ? nch - 2 - n : n + 1; load_raw(R, P, QDd, KId, ELd, row0 + 64 * ch2, h, slice, tg, col8, dv4, lane); }
        {
            const int ci = w >> 1, ji0 = 2 * (w & 1);
            f32x4 a0 = {0.f, 0.f, 0.f, 0.f}, a1 = {0.f, 0.f, 0.f, 0.f};
#pragma unroll
            for (int sb = 0; sb < 2; ++sb) {
                bf16x8 qa[4], kb0[4], kb1[4];
#pragma unroll
                for (int s4 = 0; s4 < 4; ++s4) { const int s = 4 * sb + s4;
                    qa[s4] = *(const LAS bf16x8*)(lds + OFF_QD + (16 * ci + l15) * RSQ + (32 * s + 8 * g) * 2);
                    kb0[s4] = *(const LAS bf16x8*)(lds + OFF_KI + (16 * ji0 + l15) * RS + (32 * s + 8 * g) * 2);
                    kb1[s4] = *(const LAS bf16x8*)(lds + OFF_KI + (16 * ji0 + 16 + l15) * RS + (32 * s + 8 * g) * 2); }
#pragma unroll
                for (int s4 = 0; s4 < 4; ++s4) { a0 = __builtin_amdgcn_mfma_f32_16x16x32_bf16(qa[s4], kb0[s4], a0, 0, 0, 0); a1 = __builtin_amdgcn_mfma_f32_16x16x32_bf16(qa[s4], kb1[s4], a1, 0, 0, 0); }
            }
#pragma unroll
            for (int r = 0; r < 4; ++r) { const int c = 16 * ci + 4 * g + r, j0 = 16 * ji0 + l15, j1 = j0 + 16;
                const bool k0 = dir ? (j0 >= c) : (j0 <= c), k1 = dir ? (j1 >= c) : (j1 <= c);
                *(LAS bf16*)(lds + OFF_AI + c * RSA + j0 * 2) = (bf16)(pk2(k0 ? a0[r] : 0.f, 0.f) & 0xffffu);
                *(LAS bf16*)(lds + OFF_AI + c * RSA + j1 * 2) = (bf16)(pk2(k1 ? a1[r] : 0.f, 0.f) & 0xffffu); }
        }
        f32x4 o[4];
#pragma unroll
        for (int ci = 0; ci < 4; ++ci) o[ci] = (f32x4){0.f, 0.f, 0.f, 0.f};
#pragma unroll
        for (int ib = 0; ib < 4; ++ib) {
            s16x4 lo[2][4], hi[2][4];
#pragma unroll
            for (int i2 = 0; i2 < 2; ++i2)
#pragma unroll
                for (int ci = 0; ci < 4; ++ci) { const int i = 2 * ib + i2;
                    lo[i2][ci] = *(const volatile LAS s16x4*)(lds + OFF_QD + (16 * ci + l15) * RSQ + (32 * i + 4 * g) * 2);
                    hi[i2][ci] = *(const volatile LAS s16x4*)(lds + OFF_QD + (16 * ci + l15) * RSQ + (32 * i + 16 + 4 * g) * 2); }
#pragma unroll
            for (int i2 = 0; i2 < 2; ++i2) { const int i = 2 * ib + i2;
                u32x4 sb; sb.x = pk2(S[2 * i][0], S[2 * i][1]); sb.y = pk2(S[2 * i][2], S[2 * i][3]); sb.z = pk2(S[2 * i + 1][0], S[2 * i + 1][1]); sb.w = pk2(S[2 * i + 1][2], S[2 * i + 1][3]);
                const bf16x8 sfrag = __builtin_bit_cast(bf16x8, sb);
#pragma unroll
                for (int ci = 0; ci < 4; ++ci) o[ci] = __builtin_amdgcn_mfma_f32_16x16x32_bf16(cat8(lo[i2][ci], hi[i2][ci]), sfrag, o[ci], 0, 0, 0); }
        }
        LDS_WAIT(); __builtin_amdgcn_s_barrier(); asm volatile("" ::: "memory");
        bf16x8 vf[2];
        {
            s16x4 t[4];
#pragma unroll
            for (int s = 0; s < 2; ++s) { t[2 * s] = trr(lds + OFF_V + (32 * s + 4 * g + q4) * RSV + (16 * w + 4 * p4) * 2); t[2 * s + 1] = trr(lds + OFF_V + (32 * s + 16 + 4 * g + q4) * RSV + (16 * w + 4 * p4) * 2); }
            vf[0] = cat8(t[0], t[1]); vf[1] = cat8(t[2], t[3]);
        }
        {
            s16x4 lo[4][2], hi[4][2];
#pragma unroll
            for (int ci = 0; ci < 4; ++ci)
#pragma unroll
                for (int s = 0; s < 2; ++s) { lo[ci][s] = *(const volatile LAS s16x4*)(lds + OFF_AI + (16 * ci + l15) * RSA + (32 * s + 4 * g) * 2); hi[ci][s] = *(const volatile LAS s16x4*)(lds + OFF_AI + (16 * ci + l15) * RSA + (32 * s + 16 + 4 * g) * 2); }
#pragma unroll
            for (int ci = 0; ci < 4; ++ci)
#pragma unroll
                for (int s = 0; s < 2; ++s) o[ci] = __builtin_amdgcn_mfma_f32_16x16x32_bf16(cat8(lo[ci][s], hi[ci][s]), vf[s], o[ci], 0, 0, 0);
        }
#pragma unroll
        for (int ci = 0; ci < 4; ++ci)
#pragma unroll
            for (int r = 0; r < 4; ++r) OUT[(size_t)(r0 + 16 * ci + 4 * g + r) * 2048 + h * 512 + slice * 128 + 16 * w + l15] = (bf16)(pk2(o[ci][r], 0.f) & 0xffffu);
#pragma unroll
        for (int ib = 0; ib < 4; ++ib) {
            s16x4 lo[4][2], hi[4][2]; f32x4 el[4];
#pragma unroll
            for (int i4 = 0; i4 < 4; ++i4) { const int i = 4 * ib + i4;
#pragma unroll
                for (int s = 0; s < 2; ++s) { lo[i4][s] = trr(lds + OFF_KI + (32 * s + 4 * g + q4) * RS + (16 * i + 4 * p4) * 2); hi[i4][s] = trr(lds + OFF_KI + (32 * s + 16 + 4 * g + q4) * RS + (16 * i + 4 * p4) * 2); }
                el[i4] = *(const LAS f32x4*)(lds + OFF_EL + (16 * i + 4 * g) * 4); }
#pragma unroll
            for (int i4 = 0; i4 < 4; ++i4) { const int i = 4 * ib + i4;
#pragma unroll
                for (int s = 0; s < 2; ++s) S[i] = __builtin_amdgcn_mfma_f32_16x16x32_bf16(cat8(lo[i4][s], hi[i4][s]), vf[s], S[i], 0, 0, 0);
                S[i] = S[i] * el[i4]; }
        }
        LDS_WAIT(); __builtin_amdgcn_s_barrier(); asm volatile("" ::: "memory");
    }
}
}

struct Args { const float* in[29]; float* out; unsigned char* ws; };

__global__ void __launch_bounds__(512, 2) fwd_kernel(Args args) {
    extern __shared__ __attribute__((aligned(16))) unsigned char lds_raw[];
    Frame F;
    F.lds = (LAS unsigned char*)lds_raw;
    F.MISC = (volatile LAS unsigned*)(F.lds + MISC_OFF);
    F.tid = threadIdx.x; F.lane = F.tid & 63; F.wave = __builtin_amdgcn_readfirstlane(F.tid >> 6);
    F.G = gridDim.x; { const int bx = blockIdx.x; F.vcu = (F.G % 8 == 0) ? (bx % 8) * (F.G / 8) + bx / 8 : bx; }
    F.ws = args.ws; F.ctl = (gu32*)(args.ws + WS_CTL);
    unsigned char* ws = args.ws;
    for (int u = F.tid; u < (LDS_BYTES - MISC_OFF) / 4; u += 512) ((LAS unsigned*)(F.lds + MISC_OFF))[u] = 0u;
    __syncthreads();
    if (F.tid == 0) { LAS unsigned long long* tab = (LAS unsigned long long*)(F.lds + TAB_OFF);
#define TABW(i) tab[i] = (unsigned long long)args.in[i]
        TABW(0); TABW(1); TABW(2); TABW(3); TABW(4); TABW(5); TABW(6); TABW(7); TABW(8); TABW(9); TABW(10); TABW(11); TABW(12); TABW(13); TABW(14);
        TABW(15); TABW(16); TABW(17); TABW(18); TABW(19); TABW(20); TABW(21); TABW(22); TABW(23); TABW(24); TABW(25); TABW(26); TABW(27); TABW(28);
#undef TABW
    }
    LDS_WAIT(); __syncthreads();
#define INP(i) in_ptr(F, i)
    XcdBarrier bar = xcd_barrier_post((unsigned*)(F.ctl + CW_BAR), F.MISC + 8);
#define GRID_BAR() do { xcd_barrier(bar); if ((DUPMASK >> 30) & 1) xcd_barrier(bar); } while (0)
    const int gw = F.vcu * 8 + F.wave, NGW = F.G * 8;
    const int bid = (int)blockIdx.x;

#define W_uq ((bf16*)(ws + WS_WUQ))
#define W_ukv ((bf16*)(ws + WS_WUKV))
#define W_bra ((bf16*)(ws + WS_WBRA))
#define W_brb ((bf16*)(ws + WS_WBRB))
#define W_out ((bf16*)(ws + WS_WOUT))
#define W_xq ((bf16*)(ws + WS_WXQ))
#define W_xkv ((bf16*)(ws + WS_WXKV))
#define W_xo ((bf16*)(ws + WS_WXO))
#define W_1 ((bf16*)(ws + WS_W1))
#define W_2 ((bf16*)(ws + WS_W2))
#define W_in ((bf16*)(ws + WS_WIN))
#define H ((bf16*)(ws + WS_H))
#define P ((bf16*)(ws + WS_P))
#define MEMB ((bf16*)(ws + WS_MEMB))
#define cosT ((float*)(ws + WS_ROPE))
#define sinT ((float*)(ws + WS_ROPE) + 4096 * 32)
#define rstd_q ((float*)(ws + WS_RSTD))
#define rstd_kv ((float*)(ws + WS_RSTD) + M)
#define KR ((bf16*)(ws + WS_KR))
#define CUM ((float*)(ws + WS_CUM))
#define Q ((bf16*)(ws + WS_Q))
#define KV ((bf16*)(ws + WS_KV))
#define OMLA ((bf16*)(ws + WS_OMLA))
#define GLAF ((bf16*)(ws + WS_GLAF))
#define GLAB ((bf16*)(ws + WS_GLAB))
#define OGLA ((bf16*)(ws + WS_OGLA))
#define MERGED ((bf16*)(ws + WS_MERGED))
#define GATES ((bf16*)args.out)
#define Y (args.out)
#define QX ((bf16*)(ws + WS_QX))
#define KMEM ((bf16*)(ws + WS_KMEM))
#define VT ((bf16*)(ws + WS_VT))
#define PX ((bf16*)(ws + WS_PX))
#define OX ((bf16*)(ws + WS_OX))
#define HID ((bf16*)(ws + WS_HID))

#pragma unroll
    for (int rep_ = 0; rep_ < REP(0); ++rep_) {
        LAS float* scr = (LAS float*)(F.lds + F.wave * 16384);
        constexpr int I_IN = 64 * 499, I_UQ = 16 * 96, I_UKV = 8 * 128, I_BR = 32 * 128, I_SQ = 64 * 128, I_XKV = 64 * 256, I_W1 = 64 * 512, I_W2 = 256 * 128;
        constexpr int NITEMS = I_IN + I_UQ + I_UKV + 2 * I_BR + 3 * I_SQ + I_XKV + I_W1 + I_W2;
        for (int it = gw; it < NITEMS; it += NGW) {
            int r = it;
            if (r < I_W1) { tr_item<MapId>(INP(25), 4096, 16384, W_1, scr, r, F.lane, nullptr, 1.f); continue; } r -= I_W1;
            if (r < I_W2) { tr_item<MapId>(INP(26), 16384, 4096, W_2, scr, r, F.lane, nullptr, 1.f); continue; } r -= I_W2;
            if (r < I_IN) { tr_item<MapWin>(INP(6), 4096, IN_TOTAL, W_in, scr, r, F.lane, nullptr, 1.f); continue; } r -= I_IN;
            if (r < I_XKV) { tr_item<MapId>(INP(21), 4096, 8192, W_xkv, scr, r, F.lane, nullptr, 1.f); continue; } r -= I_XKV;
            if (r < I_SQ) { tr_item<MapId>(INP(17), 4096, 4096, W_out, scr, r, F.lane, nullptr, 1.f); continue; } r -= I_SQ;
            if (r < I_SQ) { tr_item<MapId>(INP(20), 4096, 4096, W_xq, scr, r, F.lane, nullptr, CQ_XA); continue; } r -= I_SQ;
            if (r < I_SQ) { tr_item<MapId>(INP(22), 4096, 4096, W_xo, scr, r, F.lane, nullptr, 1.f); continue; } r -= I_SQ;
            if (r < I_BR) { tr_item<MapId>(INP(15), 2048, 4096, W_bra, scr, r, F.lane, nullptr, 1.f); continue; } r -= I_BR;
            if (r < I_BR) { tr_item<MapId>(INP(16), 2048, 4096, W_brb, scr, r, F.lane, nullptr, 1.f); continue; } r -= I_BR;
            if (r < I_UQ) { tr_item<MapUq>(INP(9), 1024, 3072, W_uq, scr, r, F.lane, INP(8), CQ_MLA); continue; } r -= I_UQ;
            tr_item<MapId>(INP(11), 512, 4096, W_ukv, scr, r, F.lane, INP(10), 1.f);
        }
        for (int m = gw; m < M; m += NGW) { const float* xr = m < 8192 ? INP(0) + (size_t)m * DM : INP(1) + (size_t)(m - 8192) * DM; ln_row<false>(xr, INP(4), INP(5), H + (size_t)m * DM, F.lane); }
        for (int m = gw; m < 1536; m += NGW) { const float* mr = m < 1024 ? INP(2) + (size_t)m * DM : INP(3) + (size_t)(m - 1024) * DM;
#pragma unroll
            for (int j = 0; j < 16; ++j) { const f32x4 v = ((const GAS f32x4*)mr)[F.lane + 64 * j]; u32x2 o; o.x = pk2(v.x, v.y); o.y = pk2(v.z, v.w); ((GAS u32x2*)(MEMB + (size_t)m * DM))[F.lane + 64 * j] = o; } }
        for (int e = bid * 512 + F.tid; e < 4096 * 32; e += F.G * 512) { const int pos = e >> 5, i = e & 31;
            const float inv = fexp2(-(float)i * (13.287712379549449f / 32.f));
            const double rev = (double)pos * (double)inv * 0.15915494309189535; const float fr = (float)(rev - floor(rev));
            cosT[e] = __builtin_amdgcn_cosf(fr); sinT[e] = __builtin_amdgcn_sinf(fr); }
    }
    GRID_BAR();

    { pg8::SchedStd S; S.init(64, 63, F.G, bid, H, 4096, W_in, 4096);
      pg8::EpiRow8<OpG1> E{{P, GATES, INP(7)}};
      pg8::gemm_phase<pg8::EpiRow8<OpG1>, pg8::SchedStd, true>(F.lds, 4096, 4096, 4096, S, E); }
    GRID_BAR();

#pragma unroll
    for (int rep_ = 0; rep_ < REP(2); ++rep_) {
        for (int m = gw; m < M; m += NGW) {
            const bf16* p = P + (size_t)m * NP; f32x4 a, b; float sq = 0.f, sk = 0.f;
            unpack8(*(const u32x4*)(p + PC_CQ + F.lane * 8), a, b); sq += (a[0] * a[0] + a[1] * a[1]) + (a[2] * a[2] + a[3] * a[3]) + (b[0] * b[0] + b[1] * b[1]) + (b[2] * b[2] + b[3] * b[3]);
            unpack8(*(const u32x4*)(p + PC_CQ + 512 + F.lane * 8), a, b); sq += (a[0] * a[0] + a[1] * a[1]) + (a[2] * a[2] + a[3] * a[3]) + (b[0] * b[0] + b[1] * b[1]) + (b[2] * b[2] + b[3] * b[3]);
            unpack8(*(const u32x4*)(p + PC_CKV + F.lane * 8), a, b); sk += (a[0] * a[0] + a[1] * a[1]) + (a[2] * a[2] + a[3] * a[3]) + (b[0] * b[0] + b[1] * b[1]) + (b[2] * b[2] + b[3] * b[3]);
            sq = wave_sum(sq); sk = wave_sum(sk);
            if (F.lane == 0) { rstd_q[m] = 1.f / sqrtf(sq * (1.f / 1024.f) + RMS_EPS); rstd_kv[m] = 1.f / sqrtf(sk * (1.f / 512.f) + RMS_EPS); }
            if (F.lane < 32) { const float x1 = bf1(p[PC_KROPE + F.lane]), x2 = bf1(p[PC_KROPE + 32 + F.lane]); const int pos = seq_pos(m);
                const float c = cosT[pos * 32 + F.lane], s = sinT[pos * 32 + F.lane];
                ((unsigned*)(KR + (size_t)m * 64))[F.lane] = pk2(x1 * c - x2 * s, x2 * c + x1 * s); }
        }
        LAS float* lrs = (LAS float*)F.lds;
        const float* w2 = INP(12); const float* gb = INP(13);
        bf16* const QDp = (bf16*)(ws + WS_CUM); bf16* const KIp = QDp + (size_t)2 * M * 1024; float* const ELp = (float*)(ws + WS_EL);
        for (int ch = bid; ch < M / 64; ch += F.G) {
            const int m0 = ch * 64;
            for (int idx = F.tid; idx < 64 * 32; idx += 512) lrs[idx] = bf1(P[(size_t)(m0 + (idx >> 5)) * NP + PC_GLR + (idx & 31)]);
            LDS_WAIT(); __syncthreads();
            const int dir = F.tid >> 8, key = 4 * (F.tid & 255);
            f32x4 wv[16];
#pragma unroll
            for (int r = 0; r < 16; ++r) wv[r] = *(const f32x4*)(w2 + (dir * 16 + r) * 1024 + key);
            const f32x4 gbv = *(const f32x4*)(gb + dir * 1024 + key); f32x4 run = {0.f, 0.f, 0.f, 0.f};
            bf16* qdp = QDp + (size_t)dir * M * 1024 + key; bf16* kip = KIp + (size_t)dir * M * 1024 + key;
#pragma unroll 2
            for (int tt = 0; tt < 64; ++tt) { const int t = dir ? 63 - tt : tt; const size_t row = (size_t)(m0 + t);
                const u32x2 qv = *(const u32x2*)(P + row * NP + PC_GQ + key), kv = *(const u32x2*)(P + row * NP + PC_GK + key);
                f32x4 x = gbv;
#pragma unroll
                for (int r4 = 0; r4 < 4; ++r4) { const f32x4 l = *(const LAS f32x4*)(lrs + t * 32 + dir * 16 + 4 * r4); x += wv[4 * r4] * l[0] + wv[4 * r4 + 1] * l[1] + wv[4 * r4 + 2] * l[2] + wv[4 * r4 + 3] * l[3]; }
                f32x4 e1, e2;
#pragma unroll
                for (int j = 0; j < 4; ++j) { const float la = (fminf(x[j], 0.f) - __logf(1.f + __expf(-fabsf(x[j])))) * 0.0625f; run[j] += la; e1[j] = fexp2(run[j] * LOG2E); e2[j] = fexp2(-run[j] * LOG2E); }
                u32x2 qo, ko;
                qo.x = pk2(bflo(qv.x) * e1[0] * 0.0625f, bfhi(qv.x) * e1[1] * 0.0625f); qo.y = pk2(bflo(qv.y) * e1[2] * 0.0625f, bfhi(qv.y) * e1[3] * 0.0625f);
                ko.x = pk2(bflo(kv.x) * e2[0], bfhi(kv.x) * e2[1]); ko.y = pk2(bflo(kv.y) * e2[2], bfhi(kv.y) * e2[3]);
                *(u32x2*)(qdp + row * 1024) = qo; *(u32x2*)(kip + row * 1024) = ko; }
            f32x4 el;
#pragma unroll
            for (int j = 0; j < 4; ++j) el[j] = fexp2(run[j] * LOG2E);
            *(f32x4*)(ELp + ((size_t)dir * (M / 64) + ch) * 1024 + key) = el;
            LDS_WAIT(); __syncthreads();
        }
    }
    GRID_BAR();

    { pg8::SchedStd S; S.init(64, 12, F.G, bid, P + PC_CQ, NP, W_uq, 1024);
      pg8::EpiRow8<OpQ> E{{Q, rstd_q, cosT, sinT}};
      pg8::gemm_phase<pg8::EpiRow8<OpQ>, pg8::SchedStd, true>(F.lds, 1024, NP, 1024, S, E); }
    { pg8::SchedStd S; S.init(64, 16, F.G, bid, P + PC_CKV, NP, W_ukv, 512);
      pg8::EpiRow8<OpKV> E{{KV, rstd_kv}};
      pg8::gemm_phase<pg8::EpiRow8<OpKV>, pg8::SchedStd, true>(F.lds, 512, NP, 512, S, E); }
    GRID_BAR();

#pragma unroll
    for (int rep_ = 0; rep_ < REP(4); ++rep_) {
#pragma unroll
    for (int rg_ = 0; rg_ < REP(20); ++rg_)
    if (bid < 192) gla::gla_item(P, (const bf16*)(ws + WS_CUM), (const bf16*)(ws + WS_CUM) + (size_t)2 * M * 1024, (const float*)(ws + WS_EL), GLAF, GLAB, bid, F.lds);
    for (;;) {
        if (F.tid == 0) F.MISC[16] = __hip_atomic_fetch_add((unsigned*)(F.ctl + CW_QUEUE + 64 * rep_), 1u, RLX_AGENT);
        LDS_WAIT(); __syncthreads();
        const int u = (int)F.MISC[16];
        __syncthreads();
        if (u >= 1024) break;
        int seq, h, qb, row0, S_;
        if (u < 512) { const int pair = u >> 4; qb = u & 15; seq = 4 + (pair >> 4); h = pair & 15; row0 = 8192 + (seq - 4) * 4096; S_ = 4096; }
        else { const int v = u - 512, pair = v >> 3; qb = v & 7; seq = pair >> 4; h = pair & 15; row0 = seq * 2048; S_ = 2048; }
        att::attn_unit(Q + (size_t)(row0 + qb * 256) * 3072 + h * 192, KV + (size_t)row0 * 4096 + h * 256, KV + (size_t)row0 * 4096 + h * 256 + 128, KR + (size_t)row0 * 64,
                       OMLA + (size_t)(row0 + qb * 256) * 2048 + h * 128, S_, (char*)lds_raw);
    }
    }
    GRID_BAR();

#pragma unroll
    for (int rep_ = 0; rep_ < REP(5); ++rep_) {
        const float* gn = INP(14);
        for (int m = gw; m < M; m += NGW) {
#pragma unroll
            for (int h = 0; h < 4; ++h) { const size_t base = (size_t)m * 2048 + h * 512 + F.lane * 8;
                f32x4 f0, f1, b0, b1, r0, r1; unpack8(*(const u32x4*)(GLAF + base), f0, f1); unpack8(*(const u32x4*)(GLAB + base), b0, b1);
                unpack8(*(const u32x4*)(P + (size_t)m * NP + PC_GR + h * 512 + F.lane * 8), r0, r1);
                f0 += b0; f1 += b1;
                float ss = (f0[0] * f0[0] + f0[1] * f0[1]) + (f0[2] * f0[2] + f0[3] * f0[3]) + (f1[0] * f1[0] + f1[1] * f1[1]) + (f1[2] * f1[2] + f1[3] * f1[3]);
                ss = wave_sum(ss); const float rs = 1.f / sqrtf(ss * (1.f / 512.f) + RMS_EPS);
                const f32x4 g0 = *(const f32x4*)(gn + F.lane * 8), g1 = *(const f32x4*)(gn + F.lane * 8 + 4);
#pragma unroll
                for (int j = 0; j < 4; ++j) { f0[j] = f0[j] * rs * g0[j] * (r0[j] * frcp(1.f + fexp2(-r0[j] * LOG2E))); f1[j] = f1[j] * rs * g1[j] * (r1[j] * frcp(1.f + fexp2(-r1[j] * LOG2E))); }
                *(u32x4*)(OGLA + base) = pack8(f0, f1); }
        }
    }
    GRID_BAR();

    { pg8::SchedStd S; S.init(64, 16, F.G, bid, OMLA, 2048, W_bra, 2048);
      pg8::EpiRow8<OpT> E{{MERGED, GATES}};
      pg8::gemm_phase<pg8::EpiRow8<OpT>, pg8::SchedStd, true>(F.lds, 2048, 2048, 2048, S, E); }
    { pg8::SchedStd S; S.init(64, 16, F.G, bid, OGLA, 2048, W_brb, 2048);
      pg8::EpiRow8<OpM> E{{MERGED, GATES}};
      pg8::gemm_phase<pg8::EpiRow8<OpM>, pg8::SchedStd, true>(F.lds, 2048, 2048, 2048, S, E); }
    GRID_BAR();

    { pg8::SchedStd S; S.init(64, 16, F.G, bid, MERGED, 4096, W_out, 4096);
      pg8::EpiRow8<OpY> E{{Y, H}};
      pg8::gemm_phase<pg8::EpiRow8<OpY>, pg8::SchedStd, true>(F.lds, 4096, 4096, 4096, S, E); }
    GRID_BAR();
#pragma unroll
    for (int rep_ = 0; rep_ < REP(8); ++rep_)
    for (int m = gw; m < M; m += NGW) ln_row<false>(Y + (size_t)m * DM, INP(18), INP(19), H + (size_t)m * DM, F.lane);
    GRID_BAR();

    { pg8::SchedStd S; S.init(64, 16, F.G, bid, H, 4096, W_xq, 4096);
      pg8::EpiRow8<OpPlain> E{{QX, 4096}};
      pg8::gemm_phase<pg8::EpiRow8<OpPlain>, pg8::SchedStd, true>(F.lds, 4096, 4096, 4096, S, E); }
    { SchedKVmem S{F.G, bid, (const char*)MEMB, (const char*)W_xkv};
      pg8::EpiRow8<OpKVmem> E{{KMEM, VT}};
      pg8::gemm_phase<pg8::EpiRow8<OpKVmem>, SchedKVmem, true>(F.lds, 4096, 4096, 4096, S, E); }
    GRID_BAR();
    { SchedXS S{F.G, bid, (const char*)QX, (const char*)KMEM};
      EpiSoftmax E{PX};
      pg8::gemm_phase<EpiSoftmax, SchedXS, false>(F.lds, 1024, 4096, 4096, S, E); }
    GRID_BAR();
    { SchedXO S{F.G, bid, (const char*)PX, (const char*)VT};
      pg8::EpiRow8<OpPlain> E{{OX, 4096}};
      pg8::gemm_phase<pg8::EpiRow8<OpPlain>, SchedXO, true>(F.lds, 256, 1024, 256, S, E); }
    GRID_BAR();
    { pg8::SchedStd S; S.init(64, 16, F.G, bid, OX, 4096, W_xo, 4096);
      pg8::EpiRow8<OpY> E{{Y, H}};
      pg8::gemm_phase<pg8::EpiRow8<OpY>, pg8::SchedStd, true>(F.lds, 4096, 4096, 4096, S, E); }
    GRID_BAR();
#pragma unroll
    for (int rep_ = 0; rep_ < REP(13); ++rep_)
    for (int m = gw; m < M; m += NGW) ln_row<false>(Y + (size_t)m * DM, INP(23), INP(24), H + (size_t)m * DM, F.lane);
    GRID_BAR();

#pragma unroll
    for (int rep_ = 0; rep_ < REP(14); ++rep_)
    { pg8::SchedStd S; S.init(64, 64, F.G, bid, H, 4096, W_1, 4096);
      pg8::EpiRow8<OpRelu2> E{{HID}};
      pg8::gemm_phase<pg8::EpiRow8<OpRelu2>, pg8::SchedStd, true>(F.lds, 4096, 4096, 4096, S, E); }
    GRID_BAR();
    { pg8::SchedStd S; S.init(64, 16, F.G, bid, HID, 16384, W_2, 16384);
      pg8::EpiRow8<OpY> E{{Y, H}};
      pg8::gemm_phase<pg8::EpiRow8<OpY>, pg8::SchedStd, true>(F.lds, 16384, 16384, 16384, S, E); }
    GRID_BAR();
    for (int m = gw; m < M; m += NGW) ln_row<true>(Y + (size_t)m * DM, INP(27), INP(28), Y + (size_t)m * DM, F.lane);
}

extern "C" void kernel_launch(void* const* d_in, const int* in_sizes, int n_in, void* d_out, int out_size, void* d_ws, size_t ws_size, hipStream_t stream) {
    static int grid = 0;
    if (grid == 0) {
        if (n_in != 29 || out_size != M * DM || ws_size < WS_END) { fprintf(stderr, "kernel_launch: shape mismatch: n_in %d out %d ws %zu (need %zu); nothing launched\n", n_in, out_size, ws_size, (size_t)WS_END); grid = -1; return; }
        int dev = 0, cus = 0;
        if (hipGetDevice(&dev) != hipSuccess || hipDeviceGetAttribute(&cus, hipDeviceAttributeMultiprocessorCount, dev) != hipSuccess) { grid = -1; return; }
        if (hipFuncSetAttribute((const void*)fwd_kernel, hipFuncAttributeMaxDynamicSharedMemorySize, LDS_BYTES) != hipSuccess) { fprintf(stderr, "kernel_launch: hipFuncSetAttribute failed\n"); grid = -1; return; }
        int per_cu = 0;
        if (hipOccupancyMaxActiveBlocksPerMultiprocessor(&per_cu, (const void*)fwd_kernel, 512, LDS_BYTES) != hipSuccess || per_cu < 1) fprintf(stderr, "kernel_launch: occupancy query says %d\n", per_cu);
        (void)hipGetLastError();
        grid = cus;
        if (grid != 256) fprintf(stderr, "kernel_launch: %d CUs (built for 256)\n", grid);
    }
    if (grid < 0) return;
    if (hipMemsetAsync((char*)d_ws + WS_CTL, 0, CTL_ZERO_BYTES, stream) != hipSuccess) return;
    Args a{};
    for (int i = 0; i < 29; ++i) a.in[i] = (const float*)d_in[i];
    a.out = (float*)d_out; a.ws = (unsigned char*)d_ws;
    hipLaunchKernelGGL(fwd_kernel, dim3(grid), dim3(512), LDS_BYTES, stream, a);
    const hipError_t le = hipPeekAtLastError();
    if (le != hipSuccess) fprintf(stderr, "kernel_launch: launch failed: %s\n", hipGetErrorName(le));
}
```
